# Optimizing an MI355X kernel written in HIP

```python
import functools
import jax, jax.numpy as jnp
from jax import lax
import numpy as np

D_MODEL = 1024
BATCH = 32
SEQ = 2048
DEPTH = 1
DEC_BATCH = 32
DEC_SEQ = 16
PAST_LEN = 2048

CHUNK = 64
LRU_WIDTH = D_MODEL // 2
ATTN_WIDTH = D_MODEL - LRU_WIDTH
HEAD_DIM = 64
N_HEADS = ATTN_WIDTH // HEAD_DIM
N_LRU_BLOCKS = 8
LRU_BLOCK = LRU_WIDTH // N_LRU_BLOCKS
CONV_WIDTH = 4
LRU_C = 8.0
LEFT_CHUNKS = 8
BAND = (LEFT_CHUNKS + 1) * CHUNK
MAX_REL = 128
D_FF = ((8 * D_MODEL // 3 + 255) // 256) * 256
IN_COLS = 2 * LRU_WIDTH + 3 * ATTN_WIDTH
EPS = 1e-6
CACHE_ROWS = min(LEFT_CHUNKS * CHUNK, PAST_LEN)

kernel_name = 'hymba_rglru_chunkattn_stream_step'


def rms_norm(x, g):
    xf = x.astype(jnp.float32)
    y = xf * lax.rsqrt(jnp.mean(xf * xf, axis=-1, keepdims=True) + EPS)
    return (y * g.astype(jnp.float32)).astype(x.dtype)


def causal_conv(u, buf, w, b):
    T = u.shape[1]
    up = jnp.concatenate([buf.astype(u.dtype), u], axis=1)
    y = b + up[:, 0:T] * w[0]
    for k in range(1, CONV_WIDTH):
        y = y + up[:, k:k + T] * w[k]
    return y, up[:, -(CONV_WIDTH - 1):]


def rg_lru(u, h0, w_a, b_a, w_x, b_x, lam):
    B, T, _ = u.shape
    ub = u.reshape(B, T, N_LRU_BLOCKS, LRU_BLOCK)
    r = jax.nn.sigmoid(jnp.einsum('btnc,ncd->btnd', ub, w_a).reshape(B, T, LRU_WIDTH) + b_a)
    i = jax.nn.sigmoid(jnp.einsum('btnc,ncd->btnd', ub, w_x).reshape(B, T, LRU_WIDTH) + b_x)
    log_a = (LRU_C * r.astype(jnp.float32)) * jax.nn.log_sigmoid(lam.astype(jnp.float32))
    a = jnp.exp(log_a)
    gain = jnp.sqrt(-jnp.expm1(2.0 * log_a))
    bterm = gain * (i * u).astype(jnp.float32)
    bterm = bterm.at[:, 0].add(a[:, 0] * h0.astype(jnp.float32))

    def combine(c1, c2):
        a1, b1 = c1
        a2, b2 = c2
        return a1 * a2, a2 * b1 + b2

    _, h = lax.associative_scan(combine, (a, bterm), axis=1)
    return h.astype(u.dtype), h[:, -1].astype(h0.dtype)


def attend_prompt(q, k, v, table):
    B, T, H, Dh = q.shape
    n_chunks = T // CHUNK
    pad = LEFT_CHUNKS * CHUNK
    kp = jnp.pad(k, ((0, 0), (pad, 0), (0, 0), (0, 0)))
    vp = jnp.pad(v, ((0, 0), (pad, 0), (0, 0), (0, 0)))
    qc = q.reshape(B, n_chunks, CHUNK, H, Dh).transpose(1, 0, 2, 3, 4)
    dist = jnp.arange(CHUNK)[:, None] + pad - jnp.arange(BAND)[None, :]
    bias = table[:, jnp.clip(dist, -MAX_REL, MAX_REL) + MAX_REL].astype(jnp.float32)
    scale = HEAD_DIM ** -0.5

    def one_chunk(args):
        c, qb = args
        kb = lax.dynamic_slice_in_dim(kp, c * CHUNK, BAND, axis=1)
        vb = lax.dynamic_slice_in_dim(vp, c * CHUNK, BAND, axis=1)
        s = jnp.einsum('bqhd,bkhd->bhqk', qb, kb).astype(jnp.float32) * scale + bias
        valid = jnp.arange(BAND) >= pad - c * CHUNK
        s = jnp.where(valid[None, None, None, :], s, -1e30)
        p = jax.nn.softmax(s, axis=-1).astype(vb.dtype)
        return jnp.einsum('bhqk,bkhd->bqhd', p, vb)

    o = lax.map(one_chunk, (jnp.arange(n_chunks), qc))
    return o.transpose(1, 0, 2, 3, 4).reshape(B, T, H * Dh)


def attend_sample(q, k, v, k_cache, v_cache, table):
    B, T, H, Dh = q.shape
    R = k_cache.shape[1]
    kk = jnp.concatenate([k_cache.astype(k.dtype), k], axis=1)
    vv = jnp.concatenate([v_cache.astype(v.dtype), v], axis=1)
    qpos = PAST_LEN + jnp.arange(T)
    kpos = jnp.concatenate([PAST_LEN - R + jnp.arange(R), qpos])
    dist = jnp.clip(qpos[:, None] - kpos[None, :], -MAX_REL, MAX_REL) + MAX_REL
    bias = table[:, dist].astype(jnp.float32)
    s = jnp.einsum('bqhd,bkhd->bhqk', q, kk).astype(jnp.float32) * (HEAD_DIM ** -0.5) + bias
    p = jax.nn.softmax(s, axis=-1).astype(vv.dtype)
    return jnp.einsum('bhqk,bkhd->bqhd', p, vv).reshape(B, T, H * Dh)


def layer(x, conv_buf, h0, attend, norm_mix, w_in, conv_w, conv_b, lru_wa, lru_ba, lru_wx, lru_bx,
          lru_lambda, norm_lru_out, norm_attn_out, w_out, norm_ffn, w_gate, w_up, w_down):
    B, T, _ = x.shape
    xn = rms_norm(x, norm_mix)
    proj = xn @ w_in
    splits = [LRU_WIDTH, 2 * LRU_WIDTH, 2 * LRU_WIDTH + ATTN_WIDTH, 2 * LRU_WIDTH + 2 * ATTN_WIDTH]
    u, g, q, k, v = jnp.split(proj, splits, axis=-1)
    uc, conv_new = causal_conv(u, conv_buf, conv_w, conv_b)
    h, h_last = rg_lru(uc, h0, lru_wa, lru_ba, lru_wx, lru_bx, lru_lambda)
    y_lru = jax.nn.gelu(g) * h
    q = q.reshape(B, T, N_HEADS, HEAD_DIM)
    k = k.reshape(B, T, N_HEADS, HEAD_DIM)
    v = v.reshape(B, T, N_HEADS, HEAD_DIM)
    y_att = attend(q, k, v)
    mix = jnp.concatenate([rms_norm(y_lru, norm_lru_out), rms_norm(y_att, norm_attn_out)], axis=-1) @ w_out
    x = x + mix
    xn = rms_norm(x, norm_ffn)
    x = x + (jax.nn.silu(xn @ w_gate) * (xn @ w_up)) @ w_down
    return x, conv_new, h_last, k, v


def setup_inputs(seed: int = 0) -> dict:
    key = jax.random.key(seed)
    ks = jax.random.split(key, 24)
    f32 = jnp.float32

    def nrm(k, shape, s):
        return s * jax.random.normal(k, shape, f32)

    u = jax.random.uniform(ks[14], (DEPTH, LRU_WIDTH), f32, 0.9, 0.999)
    s = u ** (1.0 / LRU_C)
    lam = jnp.log(s) - jnp.log1p(-s)
    return {
        'x_prompt': nrm(ks[0], (BATCH, SEQ, D_MODEL), 1.0),
        'x_sample': nrm(ks[1], (DEC_BATCH, DEC_SEQ, D_MODEL), 1.0),
        'state_conv': nrm(ks[2], (DEPTH, DEC_BATCH, CONV_WIDTH - 1, LRU_WIDTH), 1.0),
        'state_lru': nrm(ks[3], (DEPTH, DEC_BATCH, LRU_WIDTH), 0.5),
        'cache_k': nrm(ks[4], (DEPTH, DEC_BATCH, CACHE_ROWS, N_HEADS, HEAD_DIM), 1.0),
        'cache_v': nrm(ks[5], (DEPTH, DEC_BATCH, CACHE_ROWS, N_HEADS, HEAD_DIM), 1.0),
        'norm_mix': 1.0 + nrm(ks[6], (DEPTH, D_MODEL), 0.05),
        'w_in': nrm(ks[7], (DEPTH, D_MODEL, IN_COLS), D_MODEL ** -0.5),
        'conv_w': nrm(ks[8], (DEPTH, CONV_WIDTH, LRU_WIDTH), CONV_WIDTH ** -0.5),
        'conv_b': nrm(ks[9], (DEPTH, LRU_WIDTH), 0.02),
        'lru_wa': nrm(ks[10], (DEPTH, N_LRU_BLOCKS, LRU_BLOCK, LRU_BLOCK), LRU_BLOCK ** -0.5),
        'lru_ba': nrm(ks[11], (DEPTH, LRU_WIDTH), 0.02),
        'lru_wx': nrm(ks[12], (DEPTH, N_LRU_BLOCKS, LRU_BLOCK, LRU_BLOCK), LRU_BLOCK ** -0.5),
        'lru_bx': nrm(ks[13], (DEPTH, LRU_WIDTH), 0.02),
        'lru_lambda': lam,
        'rel_bias': nrm(ks[15], (DEPTH, N_HEADS, 2 * MAX_REL + 1), 0.1),
        'norm_lru_out': 1.0 + nrm(ks[16], (DEPTH, LRU_WIDTH), 0.05),
        'norm_attn_out': 1.0 + nrm(ks[17], (DEPTH, ATTN_WIDTH), 0.05),
        'w_out': nrm(ks[18], (DEPTH, D_MODEL, D_MODEL), D_MODEL ** -0.5),
        'norm_ffn': 1.0 + nrm(ks[19], (DEPTH, D_MODEL), 0.05),
        'w_gate': nrm(ks[20], (DEPTH, D_MODEL, D_FF), D_MODEL ** -0.5),
        'w_up': nrm(ks[21], (DEPTH, D_MODEL, D_FF), D_MODEL ** -0.5),
        'w_down': nrm(ks[22], (DEPTH, D_FF, D_MODEL), D_FF ** -0.5),
        'norm_final': 1.0 + nrm(ks[23], (D_MODEL,), 0.05),
    }


def reference(x_prompt, x_sample, state_conv, state_lru, cache_k, cache_v, norm_mix, w_in, conv_w,
              conv_b, lru_wa, lru_ba, lru_wx, lru_bx, lru_lambda, rel_bias, norm_lru_out,
              norm_attn_out, w_out, norm_ffn, w_gate, w_up, w_down, norm_final):
    xp, xs = x_prompt, x_sample
    B, T, _ = xp.shape
    keep = min(LEFT_CHUNKS * CHUNK, T)
    p_conv, p_lru, p_k, p_v = [], [], [], []
    s_conv, s_lru, s_k, s_v = [], [], [], []
    for l in range(DEPTH):
        params = (norm_mix[l], w_in[l], conv_w[l], conv_b[l], lru_wa[l], lru_ba[l], lru_wx[l],
                  lru_bx[l], lru_lambda[l], norm_lru_out[l], norm_attn_out[l], w_out[l],
                  norm_ffn[l], w_gate[l], w_up[l], w_down[l])
        conv0 = jnp.zeros((B, CONV_WIDTH - 1, LRU_WIDTH), xp.dtype)
        h0 = jnp.zeros((B, LRU_WIDTH), xp.dtype)
        att_p = functools.partial(attend_prompt, table=rel_bias[l])
        xp, cp, hp, kp, vp = layer(xp, conv0, h0, att_p, *params)
        p_conv.append(cp)
        p_lru.append(hp)
        p_k.append(kp[:, T - keep:])
        p_v.append(vp[:, T - keep:])
        att_s = functools.partial(attend_sample, k_cache=cache_k[l], v_cache=cache_v[l], table=rel_bias[l])
        xs, cs, hs, ksn, vsn = layer(xs, state_conv[l], state_lru[l], att_s, *params)
        s_conv.append(cs)
        s_lru.append(hs)
        s_k.append(ksn)
        s_v.append(vsn)
    y_prompt = rms_norm(xp, norm_final)
    y_sample = rms_norm(xs, norm_final)
    return (y_prompt, y_sample,
            jnp.stack(p_conv), jnp.stack(p_lru), jnp.stack(p_k), jnp.stack(p_v),
            jnp.stack(s_conv), jnp.stack(s_lru), jnp.stack(s_k), jnp.stack(s_v))
```

```cpp
#include <hip/hip_runtime.h>
#include <hip/hip_cooperative_groups.h>
#include <cstdio>
#include <cstdint>
#include <cmath>
namespace cg = cooperative_groups;
__device__ __forceinline__ float xr16_max(float m) { auto r = __builtin_amdgcn_permlane16_swap(__float_as_uint(m), __float_as_uint(m), false, false); return fmaxf(__uint_as_float(r[0]), __uint_as_float(r[1])); }
__device__ __forceinline__ float xr32_max(float m) { auto r = __builtin_amdgcn_permlane32_swap(__float_as_uint(m), __float_as_uint(m), false, false); return fmaxf(__uint_as_float(r[0]), __uint_as_float(r[1])); }
__device__ __forceinline__ float xr16_sum(float m) { auto r = __builtin_amdgcn_permlane16_swap(__float_as_uint(m), __float_as_uint(m), false, false); return __uint_as_float(r[0]) + __uint_as_float(r[1]); }
__device__ __forceinline__ float xr32_sum(float m) { auto r = __builtin_amdgcn_permlane32_swap(__float_as_uint(m), __float_as_uint(m), false, false); return __uint_as_float(r[0]) + __uint_as_float(r[1]); }
__device__ __forceinline__ float rows_max(float m) { return xr32_max(xr16_max(m)); }
__device__ __forceinline__ float rows_sum(float m) { return xr32_sum(xr16_sum(m)); }
namespace pg8 {
#define PG8_LAS __attribute__((address_space(3)))
typedef unsigned short bf16_t;
typedef short bf16x8 __attribute__((ext_vector_type(8)));
typedef float f32x4 __attribute__((ext_vector_type(4)));
typedef unsigned u32x4 __attribute__((ext_vector_type(4)));
constexpr int BM = 256, BK = 64, HALF = 128, HTB = HALF * BK * 2  , STAGE_BYTES = 8 * HTB, NXCD = 8, WGM = 8;

__host__ __device__ __forceinline__ int lds_byte(int r, int c) { const int st = (r >> 4) * 2 + (c >> 5), rr = r & 15, cc = c & 31, ob = rr * 64 + cc * 2; return st * 1024 + (ob ^ (((ob >> 9) & 1) << 5)); }
__host__ __device__ __forceinline__ void stage_rc(int b, int& R, int& C) { const int st = b / 1024, sb = b % 1024, swz = sb ^ (((sb >> 9) & 1) << 5); R = (st >> 1) * 16 + swz / 64; C = (st & 1) * 32 + (swz % 64) / 2; }
__host__ __device__ __forceinline__ int perm32(int rho) { const int n = rho >> 4, i = rho & 15; return 8 * (i >> 2) + 4 * n + (i & 3); }

struct Unit { int pm, pn; };
struct Gemm { const bf16_t* A; const bf16_t* Bt; int M, N, K; int ld = 0; };

struct StaticOrder {
    int nM, nN, nwg, G, c;
    __host__ __device__ void init(int M, int N, int G_, int c_) { nM = M / BM; nN = N / BM; nwg = nM * nN; G = G_; c = c_; }
    __host__ __device__ bool next(int i, Unit& u) const {
        const long L = (long)i * G + c; if (L >= nwg) return false;
        int wgid = (int)L; { const int q = nwg / NXCD, r = nwg % NXCD, xcd = wgid % NXCD, off = wgid / NXCD; wgid = (xcd < r ? xcd * (q + 1) : r * (q + 1) + (xcd - r) * q) + off; }
        const int nig = WGM * nN, gid = wgid / nig, fm = gid * WGM, gsz = (nM - fm) < WGM ? (nM - fm) : WGM;
        u.pm = fm + ((wgid % nig) % gsz); u.pn = (wgid % nig) / gsz; return true;
    }
    __device__ __forceinline__ void a_ready(const Unit&) const {}
    __device__ __forceinline__ void done(const Unit&) const {}
};

struct OneUnit {
    int pm, pn;
    __device__ __forceinline__ bool next(int i, Unit& u) const { if (i) return false; u.pm = pm; u.pn = pn; return true; }
    __device__ __forceinline__ void a_ready(const Unit&) const {}
    __device__ __forceinline__ void done(const Unit&) const {}
};
__device__ __forceinline__ unsigned cvt_pk_bf16(float lo, float hi) { unsigned r; asm volatile("v_cvt_pk_bf16_f32 %0, %1, %2" : "=v"(r) : "v"(lo), "v"(hi)); return r; }

constexpr int E_DM = 1024, E_INC = 2560, E_DFF = 2816, E_MP = 65536;
constexpr size_t EO_YS = (size_t)65536 * 1024, EO_PCONV = EO_YS + 512 * 1024, EO_PLRU = EO_PCONV + 32 * 3 * 512, EO_PK = EO_PLRU + 32 * 512, EO_PV = EO_PK + (size_t)32 * 512 * 512,
                 EO_SCONV = EO_PV + (size_t)32 * 512 * 512, EO_SLRU = EO_SCONV + 32 * 3 * 512, EO_SK = EO_SLRU + 32 * 512, EO_SV = EO_SK + 32 * 16 * 512, EO_END = EO_SV + 32 * 16 * 512;
constexpr float E_EPS = 1e-6f;

struct Epi1 {
    static constexpr bool PERM = true, AFTER_DRAIN = false, MIDSCALE = false; static constexpr int MID_T = 0;
    bf16_t* P; const float* rs1; float* out;
    __device__ __forceinline__ void mid(f32x4 (&acc)[2][2][4][2], const Unit& u, int wr, int fr, int ui) const {}
    __device__ __forceinline__ void operator()(const f32x4 (&acc)[2][2][4][2], const Unit& u, int wr, int wc, int fr, int fq, int ui) const {
        const int row0 = u.pm * BM + wr * 64 + fr, colb = u.pn * BM + wc * 32 + 8 * fq;
        const bool samp = u.pm >= 256;
        const bool kv = u.pn >= 6 && (samp || (u.pm & 7) >= 6);
        const bool cv = u.pn < 2 && (samp || (u.pm & 7) == 7);
#pragma unroll
        for (int ai = 0; ai < 2; ++ai)
#pragma unroll
            for (int m = 0; m < 4; ++m) {
                const int row = row0 + ai * HALF + m * 16;
#pragma unroll
                for (int bj = 0; bj < 2; ++bj) {
                    const int col = colb + bj * HALF;
                    const f32x4 v0 = acc[ai][bj][m][0], v1 = acc[ai][bj][m][1];
                    u32x4 w; w.x = cvt_pk_bf16(v0[0], v0[1]); w.y = cvt_pk_bf16(v0[2], v0[3]); w.z = cvt_pk_bf16(v1[0], v1[1]); w.w = cvt_pk_bf16(v1[2], v1[3]);
                    *(u32x4*)(P + (size_t)row * E_INC + col) = w;
                    if (kv) {
                        const bool isv = u.pn >= 8; const int c = col - (isv ? 2048 : 1536);
                        float* dst;
                        if (samp) dst = out + (isv ? EO_SV : EO_SK) + (size_t)(row - E_MP) * 512 + c;
                        else { const int b = row >> 11, t = row & 2047; dst = out + (isv ? EO_PV : EO_PK) + ((size_t)(b * 512 + (t - 1536)) * 512 + c); }
                        *(f32x4*)dst = v0; *(f32x4*)(dst + 4) = v1;
                    }
                    if (cv) {
                        if (samp) { const int b = (row - E_MP) >> 4, t = row & 15; if (t >= 13) { float* dst = out + EO_SCONV + ((size_t)(b * 3 + (t - 13)) * 512 + col); *(f32x4*)dst = v0; *(f32x4*)(dst + 4) = v1; } }
                        else { const int b = row >> 11, t = row & 2047; if (t >= 2045) { float* dst = out + EO_PCONV + ((size_t)(b * 3 + (t - 2045)) * 512 + col); *(f32x4*)dst = v0; *(f32x4*)(dst + 4) = v1; } }
                    }
                }
            }
    }
};

struct Epi2 {
    static constexpr bool PERM = true, AFTER_DRAIN = false, MIDSCALE = true; static constexpr int MID_T = 8;
    const float* xp; const float* xs; float* out; bf16_t* X1B; const PG8_LAS float* tab; float* ssq1;
    __device__ __forceinline__ void mid(f32x4 (&acc)[2][2][4][2], const Unit& u, int wr, int fr, int ui) const {
#pragma unroll
        for (int ai = 0; ai < 2; ++ai)
#pragma unroll
            for (int m = 0; m < 4; ++m) {
                const float rho = tab[(ui * 256 + ai * HALF + wr * 64 + m * 16 + fr) * 2];
#pragma unroll
                for (int bj = 0; bj < 2; ++bj)
#pragma unroll
                    for (int n = 0; n < 2; ++n) acc[ai][bj][m][n] = acc[ai][bj][m][n] * rho;
            }
    }
    __device__ __forceinline__ void operator()(const f32x4 (&acc)[2][2][4][2], const Unit& u, int wr, int wc, int fr, int fq, int ui) const {
        const int row0 = u.pm * BM + wr * 64 + fr, colb = u.pn * BM + wc * 32 + 8 * fq;
        const float* xbase = u.pm >= 256 ? xs - (size_t)E_MP * E_DM : xp;
#pragma unroll
        for (int ai = 0; ai < 2; ++ai)
#pragma unroll
            for (int m = 0; m < 4; ++m) {
                const int row = row0 + ai * HALF + m * 16;
                const float rsa = tab[(ui * 256 + ai * HALF + wr * 64 + m * 16 + fr) * 2 + 1];
                float ss = 0.f;
#pragma unroll
                for (int bj = 0; bj < 2; ++bj) {
                    const size_t off = (size_t)row * E_DM + colb + bj * HALF;
                    const f32x4 x0 = *(const f32x4*)(xbase + off), x1 = *(const f32x4*)(xbase + off + 4);
                    const f32x4 v0 = x0 + acc[ai][bj][m][0] * rsa, v1 = x1 + acc[ai][bj][m][1] * rsa;
                    if (u.pm >= 256) { *(f32x4*)(out + off) = v0; *(f32x4*)(out + off + 4) = v1; }
                    u32x4 w; w.x = cvt_pk_bf16(v0[0], v0[1]); w.y = cvt_pk_bf16(v0[2], v0[3]); w.z = cvt_pk_bf16(v1[0], v1[1]); w.w = cvt_pk_bf16(v1[2], v1[3]);
                    *(u32x4*)(X1B + off) = w;
                    ss += (v0[0] * v0[0] + v0[1] * v0[1]) + (v0[2] * v0[2] + v0[3] * v0[3]) + (v1[0] * v1[0] + v1[1] * v1[1]) + (v1[2] * v1[2] + v1[3] * v1[3]);
                }
                ss = rows_sum(ss);
                if (fq == 0) atomicAdd(ssq1 + row, ss);
            }
    }
};

struct Epi3 {
    static constexpr bool PERM = true, AFTER_DRAIN = false, MIDSCALE = false; static constexpr int MID_T = 0;
    bf16_t* H; const float* ssq1;
    __device__ __forceinline__ void mid(f32x4 (&acc)[2][2][4][2], const Unit& u, int wr, int fr, int ui) const {}
    __device__ __forceinline__ void operator()(const f32x4 (&acc)[2][2][4][2], const Unit& u, int wr, int wc, int fr, int fq, int ui) const {
        const int row0 = u.pm * BM + wr * 64 + fr, col = u.pn * HALF + wc * 32 + 8 * fq;
#pragma unroll
        for (int ai = 0; ai < 2; ++ai)
#pragma unroll
            for (int m = 0; m < 4; ++m) {
                const int row = row0 + ai * HALF + m * 16;
                const float rs = 1.0f / sqrtf(ssq1[row] * (1.f / 1024.f) + E_EPS);
                float hv[8];
#pragma unroll
                for (int n = 0; n < 2; ++n)
#pragma unroll
                    for (int j = 0; j < 4; ++j) {
                        const float g = acc[ai][0][m][n][j] * rs, up = acc[ai][1][m][n][j] * rs;
                        const float sg = g * __builtin_amdgcn_rcpf(1.0f + __builtin_amdgcn_exp2f(-1.44269504f * g));
                        hv[n * 4 + j] = sg * up;
                    }
                u32x4 w; w.x = cvt_pk_bf16(hv[0], hv[1]); w.y = cvt_pk_bf16(hv[2], hv[3]); w.z = cvt_pk_bf16(hv[4], hv[5]); w.w = cvt_pk_bf16(hv[6], hv[7]);
                *(u32x4*)(H + (size_t)row * E_DFF + col) = w;
            }
    }
};

struct Epi4N {
    static constexpr bool PERM = true, AFTER_DRAIN = false, MIDSCALE = false; static constexpr int MID_T = 0;
    float* out; const bf16_t* X1B; const float* gfin; float* slots; unsigned* cnt; PG8_LAS unsigned char* xl;
    __device__ __forceinline__ void mid(f32x4 (&acc)[2][2][4][2], const Unit& u, int wr, int fr, int ui) const {}
    __device__ __forceinline__ void operator()(const f32x4 (&acc)[2][2][4][2], const Unit& u, int wr, int wc, int fr, int fq, int ui) const {
        const int row0 = u.pm * BM + wr * 64 + fr, colb = u.pn * BM + wc * 32 + 8 * fq;
        PG8_LAS float* P = (PG8_LAS float*)xl; PG8_LAS float* S = (PG8_LAS float*)(xl + 4096);
        int tid_ = threadIdx.x; asm volatile("" : "+v"(tid_)); const int tid = tid_;
        f32x4 v[2][4][2][2];
#pragma unroll
        for (int ai = 0; ai < 2; ++ai)
#pragma unroll
            for (int m = 0; m < 4; ++m) {
                const int row = row0 + ai * HALF + m * 16; float ss = 0.f;
#pragma unroll
                for (int bj = 0; bj < 2; ++bj) {
                    const size_t off = (size_t)row * E_DM + colb + bj * HALF;
                    const u32x4 xb = *(const u32x4*)(X1B + off);
                    const f32x4 v0 = (f32x4){__uint_as_float(xb.x << 16), __uint_as_float(xb.x & 0xffff0000u), __uint_as_float(xb.y << 16), __uint_as_float(xb.y & 0xffff0000u)} + acc[ai][bj][m][0];
                    const f32x4 v1 = (f32x4){__uint_as_float(xb.z << 16), __uint_as_float(xb.z & 0xffff0000u), __uint_as_float(xb.w << 16), __uint_as_float(xb.w & 0xffff0000u)} + acc[ai][bj][m][1];
                    v[ai][m][bj][0] = v0; v[ai][m][bj][1] = v1;
                    ss += (v0[0] * v0[0] + v0[1] * v0[1]) + (v0[2] * v0[2] + v0[3] * v0[3]) + (v1[0] * v1[0] + v1[1] * v1[1]) + (v1[2] * v1[2] + v1[3] * v1[3]);
                }
                ss = rows_sum(ss);
                if (fq == 0) P[(ai * HALF + wr * 64 + m * 16 + fr) * 4 + wc] = ss;
            }
        asm volatile("s_waitcnt lgkmcnt(0)" ::: "memory"); __builtin_amdgcn_s_barrier(); asm volatile("" ::: "memory");
        if (tid < 256) { const float tot = (P[tid * 4] + P[tid * 4 + 1]) + (P[tid * 4 + 2] + P[tid * 4 + 3]);
            __hip_atomic_store(slots + ((size_t)(u.pm * BM + tid)) * 4 + u.pn, tot, __ATOMIC_RELAXED, __HIP_MEMORY_SCOPE_AGENT); }
        asm volatile("s_waitcnt vmcnt(0)" ::: "memory"); __builtin_amdgcn_s_barrier(); asm volatile("" ::: "memory");
        if (tid == 0) {
            __hip_atomic_fetch_add(cnt + 64 * u.pm, 1u, __ATOMIC_RELAXED, __HIP_MEMORY_SCOPE_AGENT);
            unsigned spins = 0; while (__hip_atomic_load(cnt + 64 * u.pm, __ATOMIC_RELAXED, __HIP_MEMORY_SCOPE_AGENT) < 4u && ++spins < (1u << 20)) __builtin_amdgcn_s_sleep(2);
        }
        asm volatile("s_waitcnt vmcnt(0) lgkmcnt(0)" ::: "memory"); __builtin_amdgcn_s_barrier(); asm volatile("" ::: "memory");
        if (tid < 256) { const float* sl = slots + ((size_t)(u.pm * BM + tid)) * 4;
            const float tot = (__hip_atomic_load(sl, __ATOMIC_RELAXED, __HIP_MEMORY_SCOPE_AGENT) + __hip_atomic_load(sl + 1, __ATOMIC_RELAXED, __HIP_MEMORY_SCOPE_AGENT))
                            + (__hip_atomic_load(sl + 2, __ATOMIC_RELAXED, __HIP_MEMORY_SCOPE_AGENT) + __hip_atomic_load(sl + 3, __ATOMIC_RELAXED, __HIP_MEMORY_SCOPE_AGENT));
            S[tid] = 1.0f / sqrtf(tot * (1.f / 1024.f) + E_EPS); }
        asm volatile("s_waitcnt vmcnt(0) lgkmcnt(0)" ::: "memory"); __builtin_amdgcn_s_barrier(); asm volatile("" ::: "memory");
        f32x4 gg[2][2];
#pragma unroll
        for (int bj = 0; bj < 2; ++bj) { gg[bj][0] = *(const f32x4*)(gfin + colb + bj * HALF); gg[bj][1] = *(const f32x4*)(gfin + colb + bj * HALF + 4); }
#pragma unroll
        for (int ai = 0; ai < 2; ++ai)
#pragma unroll
            for (int m = 0; m < 4; ++m) {
                const int row = row0 + ai * HALF + m * 16; const float rs = S[ai * HALF + wr * 64 + m * 16 + fr];
#pragma unroll
                for (int bj = 0; bj < 2; ++bj) { const size_t off = (size_t)row * E_DM + colb + bj * HALF;
                    *(f32x4*)(out + off) = v[ai][m][bj][0] * rs * gg[bj][0]; *(f32x4*)(out + off + 4) = v[ai][m][bj][1] * rs * gg[bj][1]; }
            }
        asm volatile("s_waitcnt lgkmcnt(0)" ::: "memory"); __builtin_amdgcn_s_barrier(); asm volatile("" ::: "memory");
    }
};

struct Epi4P {
    static constexpr bool PERM = true, AFTER_DRAIN = false, MIDSCALE = false; static constexpr int MID_T = 0;
    float* part;
    __device__ __forceinline__ void mid(f32x4 (&acc)[2][2][4][2], const Unit& u, int wr, int fr, int ui) const {}
    __device__ __forceinline__ void operator()(const f32x4 (&acc)[2][2][4][2], const Unit& u, int wr, int wc, int fr, int fq, int ui) const {
        const int row0 = (u.pm - 256) * BM + wr * 64 + fr, colb = u.pn * BM + wc * 32 + 8 * fq;
#pragma unroll
        for (int ai = 0; ai < 2; ++ai)
#pragma unroll
            for (int m = 0; m < 4; ++m)
#pragma unroll
                for (int bj = 0; bj < 2; ++bj) { float* dst = part + (size_t)(row0 + ai * HALF + m * 16) * E_DM + colb + bj * HALF; *(f32x4*)dst = acc[ai][bj][m][0]; *(f32x4*)(dst + 4) = acc[ai][bj][m][1]; }
    }
};

struct Epi4 {
    static constexpr bool PERM = true, AFTER_DRAIN = false, MIDSCALE = false; static constexpr int MID_T = 0;
    float* out; float* ssq2;
    __device__ __forceinline__ void mid(f32x4 (&acc)[2][2][4][2], const Unit& u, int wr, int fr, int ui) const {}
    __device__ __forceinline__ void operator()(const f32x4 (&acc)[2][2][4][2], const Unit& u, int wr, int wc, int fr, int fq, int ui) const {
        const int row0 = u.pm * BM + wr * 64 + fr, colb = u.pn * BM + wc * 32 + 8 * fq;
#pragma unroll
        for (int ai = 0; ai < 2; ++ai)
#pragma unroll
            for (int m = 0; m < 4; ++m) {
                const int row = row0 + ai * HALF + m * 16;
                float ss = 0.f;
#pragma unroll
                for (int bj = 0; bj < 2; ++bj) {
                    const size_t off = (size_t)row * E_DM + colb + bj * HALF;
                    const f32x4 x0 = *(const f32x4*)(out + off), x1 = *(const f32x4*)(out + off + 4);
                    const f32x4 v0 = x0 + acc[ai][bj][m][0], v1 = x1 + acc[ai][bj][m][1];
                    *(f32x4*)(out + off) = v0; *(f32x4*)(out + off + 4) = v1;
                    ss += (v0[0] * v0[0] + v0[1] * v0[1]) + (v0[2] * v0[2] + v0[3] * v0[3]) + (v1[0] * v1[0] + v1[1] * v1[1]) + (v1[2] * v1[2] + v1[3] * v1[3]);
                }
                ss = rows_sum(ss);
                if (fq == 0) atomicAdd(ssq2 + row, ss);
            }
    }
};

template <class Epi, class Sched, bool ALIGN_EPI = false, bool SP2 = false>
__device__ __forceinline__ void gemm_phase(PG8_LAS unsigned char* lds, const Gemm g, const Sched& S, const Epi& E) {
    const int tid = threadIdx.x, wid = __builtin_amdgcn_readfirstlane(tid >> 6), lane = tid & 63, wr = wid >> 2, wc = wid & 3, fr = lane & 15, fq = lane >> 4;
    const int K = g.ld ? g.ld : g.K, nt = g.K / BK;
    unsigned voffA[2], voffB[2];
#pragma unroll
    for (int i = 0; i < 2; ++i) { int R, C; stage_rc(tid * 16 + i * 8192, R, C); const int Rb = Epi::PERM ? ((R & ~31) + perm32(R & 31)) : R;
        voffA[i] = (unsigned)(R * K + C) * 2u; voffB[i] = (unsigned)(Rb * K + C) * 2u; }
    const size_t kstep = (size_t)(BK * 2);
    const size_t hstep = (size_t)HALF * K * 2;
    const size_t tstep = 2 * hstep;
    const unsigned ldsw = (unsigned)wid * 1024u;
    const int aoff = lds_byte(wr * 64 + fr, fq * 8), boff = lds_byte(wc * 32 + fr, fq * 8);
#define PG8_SA(b, h) (((b) * 2 + (h)) * HTB)
#define PG8_SB(b, h) ((4 + (b) * 2 + (h)) * HTB)
#define PG8_STAGE(bufoff, gbase, voff) do { _Pragma("unroll") for (int _i = 0; _i < 2; ++_i) \
        __builtin_amdgcn_global_load_lds((const unsigned*)((const char*)(gbase) + (voff)[_i]), (PG8_LAS unsigned*)(lds + (bufoff) + ldsw + _i * 8192), 16, 0, 0); } while (0)
#define PG8_LDA(dst, b, h) do { _Pragma("unroll") for (int m = 0; m < 4; ++m) _Pragma("unroll") for (int k = 0; k < 2; ++k) dst[m][k] = *(const PG8_LAS bf16x8*)(lds + PG8_SA(b, h) + aoff + m * 2048 + k * 1024); } while (0)
#define PG8_LDB(dst, b, h) do { _Pragma("unroll") for (int n = 0; n < 2; ++n) _Pragma("unroll") for (int k = 0; k < 2; ++k) dst[n][k] = *(const PG8_LAS bf16x8*)(lds + PG8_SB(b, h) + boff + n * 2048 + k * 1024); } while (0)
#define PG8_MMA(ai, bj, At, Bt) do { __builtin_amdgcn_s_setprio(1); _Pragma("unroll") for (int m = 0; m < 4; ++m) _Pragma("unroll") for (int n = 0; n < 2; ++n) _Pragma("unroll") for (int k = 0; k < 2; ++k) \
        acc[ai][bj][m][n] = __builtin_amdgcn_mfma_f32_16x16x32_bf16(Bt[n][k], At[m][k], acc[ai][bj][m][n], 0, 0, 0); __builtin_amdgcn_s_setprio(0); } while (0)
#define PG8_WAIT_V(n) asm volatile("s_waitcnt vmcnt(" #n ")" ::: "memory")
#define PG8_WAIT_L(n) asm volatile("s_waitcnt lgkmcnt(" #n ")" ::: "memory")
#define PG8_BAR __builtin_amdgcn_s_barrier()
#define PG8_SCHED __builtin_amdgcn_sched_barrier(0)
    Unit cur, nxt; int ui = 0;
    if (!S.next(0, cur)) return;
    f32x4 acc[2][2][4][2];
#pragma unroll
    for (int a = 0; a < 2; ++a)
#pragma unroll
        for (int b = 0; b < 2; ++b)
#pragma unroll
            for (int m = 0; m < 4; ++m)
#pragma unroll
                for (int n = 0; n < 2; ++n) acc[a][b][m][n] = (f32x4){0.f, 0.f, 0.f, 0.f};
    bf16x8 At[4][2], B0[2][2], B1[2][2];
    const char* cA = (const char*)g.A + (size_t)cur.pm * tstep; const char* cB = (const char*)g.Bt + (size_t)cur.pn * tstep;
    S.a_ready(cur);
    if constexpr (SP2) {
        PG8_STAGE(PG8_SB(0, 0), cB, voffB); PG8_STAGE(PG8_SB(0, 1), cB + hstep, voffB); PG8_STAGE(PG8_SA(0, 0), cA, voffA); PG8_STAGE(PG8_SA(0, 1), cA + hstep, voffA);
        if (wr == 1) PG8_BAR;
        PG8_WAIT_V(2); PG8_BAR;
        PG8_STAGE(PG8_SB(1, 0), cB + kstep, voffB); PG8_STAGE(PG8_SA(1, 0), cA + kstep, voffA); PG8_STAGE(PG8_SB(1, 1), cB + hstep + kstep, voffB);
        PG8_WAIT_V(6); PG8_BAR;
    } else {
        PG8_STAGE(PG8_SB(0, 0), cB, voffB); PG8_STAGE(PG8_SA(0, 0), cA, voffA); PG8_STAGE(PG8_SB(0, 1), cB + hstep, voffB); PG8_STAGE(PG8_SA(0, 1), cA + hstep, voffA);
        if (wr == 1) PG8_BAR;
        PG8_WAIT_V(4); PG8_BAR;
        PG8_STAGE(PG8_SB(1, 0), cB + kstep, voffB); PG8_STAGE(PG8_SA(1, 0), cA + kstep, voffA); PG8_STAGE(PG8_SB(1, 1), cB + hstep + kstep, voffB);
        PG8_WAIT_V(6); PG8_BAR;
    }
    for (;;) {
        const bool has_next = S.next(ui + 1, nxt);
        const char* nA = has_next ? (const char*)g.A + (size_t)nxt.pm * tstep : cA; const char* nB = has_next ? (const char*)g.Bt + (size_t)nxt.pn * tstep : cB;
        for (int t = 0; t < nt; t += 2) {
            if constexpr (Epi::MIDSCALE) { if (t == Epi::MID_T) E.mid(acc, cur, wr, fr, ui); }
            const bool last = (t == nt - 2);
            const char* a1 = cA + (size_t)(t + 1) * kstep;
            const char* a2 = last ? nA : cA + (size_t)(t + 2) * kstep; const char* b2 = last ? nB : cB + (size_t)(t + 2) * kstep;
            const char* a3 = a2 + kstep; const char* b3 = b2 + kstep;
            if (last && has_next) S.a_ready(nxt);
            if constexpr (SP2) {
            PG8_LDB(B0, 0, 0); PG8_LDB(B1, 0, 1); PG8_SCHED; PG8_LDA(At, 0, 0); PG8_STAGE(PG8_SA(1, 1), a1 + hstep, voffA);
            PG8_WAIT_V(8); PG8_WAIT_L(0); PG8_BAR; PG8_MMA(0, 0, At, B0); PG8_MMA(0, 1, At, B1); PG8_BAR; PG8_SCHED;
            PG8_LDA(At, 0, 1); PG8_STAGE(PG8_SB(0, 0), b2, voffB); PG8_STAGE(PG8_SB(0, 1), b2 + hstep, voffB); PG8_STAGE(PG8_SA(0, 0), a2, voffA);
            PG8_WAIT_V(8); PG8_WAIT_L(0); PG8_BAR; PG8_MMA(1, 0, At, B0); PG8_MMA(1, 1, At, B1); PG8_BAR; PG8_SCHED;
            PG8_LDB(B0, 1, 0); PG8_LDB(B1, 1, 1); PG8_SCHED; PG8_LDA(At, 1, 0); PG8_STAGE(PG8_SA(0, 1), a2 + hstep, voffA);
            PG8_WAIT_V(8); PG8_WAIT_L(0); PG8_BAR; PG8_MMA(0, 0, At, B0); PG8_MMA(0, 1, At, B1); PG8_BAR; PG8_SCHED;
            PG8_LDA(At, 1, 1); PG8_STAGE(PG8_SB(1, 0), b3, voffB); PG8_STAGE(PG8_SB(1, 1), b3 + hstep, voffB); PG8_STAGE(PG8_SA(1, 0), a3, voffA);
            PG8_WAIT_V(8); PG8_WAIT_L(0); PG8_BAR; PG8_MMA(1, 0, At, B0); PG8_MMA(1, 1, At, B1); PG8_BAR; PG8_SCHED;
            } else {
            PG8_LDB(B0, 0, 0); PG8_SCHED; PG8_LDA(At, 0, 0); PG8_STAGE(PG8_SA(1, 1), a1 + hstep, voffA);
            PG8_WAIT_L(8); PG8_BAR; PG8_WAIT_L(0); PG8_MMA(0, 0, At, B0); PG8_BAR; PG8_SCHED;
            PG8_LDB(B1, 0, 1); PG8_STAGE(PG8_SB(0, 0), b2, voffB);
            PG8_BAR; PG8_WAIT_L(0); PG8_MMA(0, 1, At, B1); PG8_BAR;
            PG8_LDA(At, 0, 1); PG8_STAGE(PG8_SA(0, 0), a2, voffA);
            PG8_BAR; PG8_WAIT_L(0); PG8_MMA(1, 0, At, B0); PG8_BAR; PG8_SCHED;
            PG8_STAGE(PG8_SB(0, 1), b2 + hstep, voffB);
            PG8_WAIT_V(6); PG8_BAR; PG8_MMA(1, 1, At, B1); PG8_BAR;
            PG8_LDB(B0, 1, 0); PG8_SCHED; PG8_LDA(At, 1, 0); PG8_STAGE(PG8_SA(0, 1), a2 + hstep, voffA);
            PG8_WAIT_L(8); PG8_BAR; PG8_WAIT_L(0); PG8_MMA(0, 0, At, B0); PG8_BAR; PG8_SCHED;
            PG8_LDB(B1, 1, 1); PG8_STAGE(PG8_SB(1, 0), b3, voffB);
            PG8_BAR; PG8_WAIT_L(0); PG8_MMA(0, 1, At, B1); PG8_BAR;
            PG8_LDA(At, 1, 1); PG8_STAGE(PG8_SA(1, 0), a3, voffA);
            PG8_BAR; PG8_WAIT_L(0); PG8_MMA(1, 0, At, B0); PG8_BAR; PG8_SCHED;
            PG8_STAGE(PG8_SB(1, 1), b3 + hstep, voffB);
            PG8_WAIT_V(6); PG8_BAR; PG8_MMA(1, 1, At, B1); PG8_BAR;
            }
        }
        if constexpr (ALIGN_EPI) { if (wr == 0) PG8_BAR; }
        if constexpr (!Epi::AFTER_DRAIN) { E(acc, cur, wr, wc, fr, fq, ui); S.done(cur); }
        if (!has_next) break;
#pragma unroll
        for (int a = 0; a < 2; ++a)
#pragma unroll
            for (int b = 0; b < 2; ++b)
#pragma unroll
                for (int m = 0; m < 4; ++m)
#pragma unroll
                    for (int n = 0; n < 2; ++n) acc[a][b][m][n] = (f32x4){0.f, 0.f, 0.f, 0.f};
        cur = nxt; cA = nA; cB = nB; ++ui;
        if constexpr (ALIGN_EPI) { if (wr == 1) PG8_BAR; }
    }
    PG8_WAIT_V(0);
    if constexpr (!ALIGN_EPI) { if (wr == 0) PG8_BAR; }
    PG8_BAR;
    if constexpr (Epi::AFTER_DRAIN) { E.fused(acc, cur, wr, wc, fr, fq, lds, wid, lane); S.done(cur); }
#undef PG8_SA
#undef PG8_SB
#undef PG8_STAGE
#undef PG8_LDA
#undef PG8_LDB
#undef PG8_MMA
#undef PG8_WAIT_V
#undef PG8_WAIT_L
#undef PG8_BAR
#undef PG8_SCHED
}
}

#ifndef PG8_SP2
#define PG8_SP2 true
#endif
#ifndef PG8_ALIGN
#define PG8_ALIGN true
#endif

#define LAS __attribute__((address_space(3)))
typedef unsigned short bf16_t;
typedef short bf16x8 __attribute__((ext_vector_type(8)));
typedef short s16x4 __attribute__((ext_vector_type(4)));
typedef float f32x4 __attribute__((ext_vector_type(4)));
typedef unsigned u32x4 __attribute__((ext_vector_type(4)));
typedef unsigned u32x2 __attribute__((ext_vector_type(2)));

constexpr int NWAVES = 8, NTHR = 512;
constexpr int DM = 1024, SEQ = 2048, NB = 32, DSEQ = 16, LW = 512, NH = 8, HD = 64, DFF = 2816, INC = 2560;
constexpr int MP = NB * SEQ, MS = NB * DSEQ, MT = MP + MS;
constexpr float EPS = 1e-6f, LOG2E = 1.4426950408889634f;
constexpr int LDS_BYTES = 147456;

constexpr size_t MiB = 1u << 20;
constexpr size_t WS_CTR = 3 * (1u << 20);
constexpr size_t WS_PCNT = 3 * (1u << 20) + 131072;
constexpr size_t WS_BAR = 3 * (1u << 20) + 65536;
constexpr size_t WS_SSQL = 0, WS_SSQA = 512 * 1024, WS_SSQ1 = 1024 * 1024, WS_SSQ2 = 1536 * 1024, WS_RS1 = 2 * MiB;
constexpr size_t WS_W1 = 4 * MiB, WS_W2 = 9 * MiB, WS_W3 = 11 * MiB, WS_W4 = 22 * MiB, WS_CK = 28 * MiB, WS_CV = 44 * MiB;
constexpr size_t WS_H = 64 * MiB;
constexpr size_t WS_XB = 420 * MiB;
constexpr size_t WS_Y = 552 * MiB;
constexpr size_t WS_SSQP = 684 * MiB;
constexpr size_t WS_PART = 690 * MiB;
constexpr size_t WS_SLOT = 714 * MiB;
constexpr size_t WS_END = 716 * MiB;

struct Params {
    const float* in[24];
    float* out;
    unsigned char* ws;
};

__device__ __forceinline__ float bf2f(unsigned short b) { return __uint_as_float((unsigned)b << 16); }
__device__ __forceinline__ unsigned pk2(float lo, float hi) { return pg8::cvt_pk_bf16(lo, hi); }
__device__ __forceinline__ float wave_sum(float v) {
#pragma unroll
    for (int o = 1; o < 64; o <<= 1) v += __shfl_xor(v, o);
    return v;
}
__device__ __forceinline__ float fast_sigmoid(float z) { return __builtin_amdgcn_rcpf(1.0f + __builtin_amdgcn_exp2f(-LOG2E * z)); }
__device__ __forceinline__ float gelu_tanh(float x) {
    const float z = 0.7978845608028654f * (x + 0.044715f * x * x * x);
    const float e = __builtin_amdgcn_exp2f(2.0f * LOG2E * z);
    const float th = 1.0f - 2.0f * __builtin_amdgcn_rcpf(e + 1.0f);
    return 0.5f * x * (1.0f + th);
}

__device__ __forceinline__ void p0_transpose_item(const float* W, int K, int N, const float* g0, const float* g1, bf16_t* WT, int dst_row0, int k0, int n0, float* scr, int lane) {
#pragma unroll 8
    for (int i = 0; i < 32; ++i) { const int kk = 2 * i + (lane >> 5); const int k = k0 + kk;
        float sc = 1.f; if (g0) sc = (g1 && k >= 512) ? g1[k - 512] : g0[k];
        scr[kk * 33 + (lane & 31)] = W[(size_t)k * N + n0 + (lane & 31)] * sc; }
    asm volatile("s_waitcnt lgkmcnt(0)" ::: "memory");
    const int c = lane & 7;
#pragma unroll
    for (int j = 0; j < 4; ++j) { const int n = (lane >> 3) + 8 * j; const float* s = scr + (8 * c) * 33 + n;
        u32x4 o; o.x = pk2(s[0 * 33], s[1 * 33]); o.y = pk2(s[2 * 33], s[3 * 33]); o.z = pk2(s[4 * 33], s[5 * 33]); o.w = pk2(s[6 * 33], s[7 * 33]);
        *(u32x4*)(WT + (size_t)(dst_row0 + n0 + n) * K + k0 + 8 * c) = o; }
    asm volatile("s_waitcnt lgkmcnt(0)" ::: "memory");
}

__device__ __forceinline__ void p0_weights(const Params& p, unsigned char* lds, int tid, int lo, int hi, int wg0, int nwg) {
    const int lane = tid & 63, wave = tid >> 6;
    float* scr = (float*)(lds + wave * 16384);
    unsigned char* ws = p.ws;
    bf16_t* W1 = (bf16_t*)(ws + WS_W1); bf16_t* W2 = (bf16_t*)(ws + WS_W2); bf16_t* W3 = (bf16_t*)(ws + WS_W3); bf16_t* W4 = (bf16_t*)(ws + WS_W4);
    constexpr int I1 = 16 * 80, I2 = 16 * 32, I3 = 16 * 88;
    if ((int)blockIdx.x < wg0 || (int)blockIdx.x >= wg0 + nwg) return;
    for (int it = lo + ((int)blockIdx.x - wg0) * NWAVES + wave; it < hi; it += nwg * NWAVES) {
        int r = it;
        if (r < I1) { const int kb = r / 80, nb = r % 80; p0_transpose_item(p.in[7], DM, INC, p.in[6], nullptr, W1, 0, kb * 64, nb * 32, scr, lane); continue; } r -= I1;
        if (r < I2) { const int kb = r / 32, nb = r % 32; p0_transpose_item(p.in[18], DM, DM, p.in[16], p.in[17], W2, 0, kb * 64, nb * 32, scr, lane); continue; } r -= I2;
        if (r < I3) { const int kb = r / 88, nb = r % 88; const int n0 = nb * 32; p0_transpose_item(p.in[20], DM, DFF, p.in[19], nullptr, W3, 256 * (n0 / 128) + (n0 % 128) - n0, kb * 64, n0, scr, lane); continue; } r -= I3;
        if (r < I3) { const int kb = r / 88, nb = r % 88; const int n0 = nb * 32; p0_transpose_item(p.in[21], DM, DFF, p.in[19], nullptr, W3, 256 * (n0 / 128) + 128 + (n0 % 128) - n0, kb * 64, n0, scr, lane); continue; } r -= I3;
        { const int kb = r / 32, nb = r % 32; p0_transpose_item(p.in[22], DFF, DM, nullptr, nullptr, W4, 0, kb * 64, nb * 32, scr, lane); }
    }
}
constexpr int WI_1 = 16 * 80, WI_2 = WI_1 + 16 * 32, WI_END = WI_2 + 2 * 16 * 88 + 44 * 32;
__device__ __forceinline__ void p0_cache(const Params& p, int tid, int wg0, int nwg) {
    if ((int)blockIdx.x < wg0 || (int)blockIdx.x >= wg0 + nwg) return;
    unsigned char* ws = p.ws;
    const int gt = ((int)blockIdx.x - wg0) * NTHR + tid, NGT = nwg * NTHR;
    bf16_t* CK = (bf16_t*)(ws + WS_CK); bf16_t* CV = (bf16_t*)(ws + WS_CV);
    constexpr int NC8 = NB * 512 * 512 / 8;
    for (int i0 = gt; i0 < 2 * NC8; i0 += 4 * NGT) {
        f32x4 a[4], b[4];
#pragma unroll
        for (int u = 0; u < 4; ++u) { const int i = i0 + u * NGT; if (i < 2 * NC8) { const int which = i >= NC8; const int e = (which ? i - NC8 : i);
            const f32x4* src = (const f32x4*)(which ? p.in[5] : p.in[4]) + (size_t)e * 2; a[u] = src[0]; b[u] = src[1]; } }
#pragma unroll
        for (int u = 0; u < 4; ++u) { const int i = i0 + u * NGT; if (i < 2 * NC8) { const int which = i >= NC8; const int e = (which ? i - NC8 : i);
            u32x4 w; w.x = pk2(a[u].x, a[u].y); w.y = pk2(a[u].z, a[u].w); w.z = pk2(b[u].x, b[u].y); w.w = pk2(b[u].z, b[u].w);
            *((u32x4*)(which ? CV : CK) + e) = w; } }
    }
}
__device__ __forceinline__ void p0_prologue(const Params& p, unsigned char* lds, int tid, int G) {
    const int lane = tid & 63, wave = tid >> 6;
    const int gw = blockIdx.x * NWAVES + wave, NGW = G * NWAVES;
    unsigned char* ws = p.ws;
    p0_weights(p, lds, tid, 0, WI_1, 0, G);
    bf16_t* XB = (bf16_t*)(ws + WS_XB); float* rs1 = (float*)(ws + WS_RS1);
    for (int m0 = 4 * gw; m0 < MT; m0 += 4 * NGW) {
        f32x4 v[4][4];
#pragma unroll
        for (int r = 0; r < 4; ++r) { const int m = m0 + r; const float* xrow = m < MP ? p.in[0] + (size_t)m * DM : p.in[1] + (size_t)(m - MP) * DM;
            const f32x4* xr = (const f32x4*)xrow + lane;
#pragma unroll
            for (int j = 0; j < 4; ++j) v[r][j] = xr[64 * j]; }
#pragma unroll
        for (int r = 0; r < 4; ++r) { const int m = m0 + r; float s = 0.f;
#pragma unroll
            for (int j = 0; j < 4; ++j) s += (v[r][j].x * v[r][j].x + v[r][j].y * v[r][j].y) + (v[r][j].z * v[r][j].z + v[r][j].w * v[r][j].w);
            s = wave_sum(s);
            const float rs = 1.0f / sqrtf(s * (1.f / DM) + EPS);
            u32x2* o8 = (u32x2*)(XB + (size_t)m * DM) + lane;
#pragma unroll
            for (int j = 0; j < 4; ++j) { u32x2 w; w.x = pk2(v[r][j].x * rs, v[r][j].y * rs); w.y = pk2(v[r][j].z * rs, v[r][j].w * rs); o8[64 * j] = w; } }
    }
    const int gt = blockIdx.x * NTHR + tid, NGT = G * NTHR;
    float* z0 = (float*)(ws + WS_SSQL); float* z1 = (float*)(ws + WS_SSQA); float* z2 = (float*)(ws + WS_SSQ1); float* z3 = (float*)(ws + WS_SSQ2);
    for (int i = gt; i < MT; i += NGT) { z2[i] = 0.f; z3[i] = 0.f; }
    if (gt < 8) *((unsigned*)(ws + WS_CTR) + 64 * gt) = 0u;
    for (int i = gt; i < 3456; i += NGT) ((unsigned*)(ws + WS_BAR))[i] = 0u;
    for (int i = gt; i < 256 * 64; i += NGT) ((unsigned*)(ws + WS_PCNT))[i] = 0u;
}

#define LDS_BAR() asm volatile("s_waitcnt lgkmcnt(0)\n\ts_barrier" ::: "memory")
constexpr int L_WA = 0, L_WX = 9216, L_U = 18432, L_UC = 35584, L_UCB = 53248, L_A = 62464, L_BT = 79872, L_SEGA = 97280, L_SEGB = 99328, L_CW = 101376, L_GL = 102656, L_END = 110848;
constexpr int FS = 68;
__device__ __forceinline__ void lru_item(const Params& p, unsigned char* lds, int tid, int b, int n, bool samp, float* ssqL) {
    asm volatile("" : "+v"(tid));
    const int lane = tid & 63, w = tid >> 6, fr = lane & 15, g = lane >> 4;
    unsigned char* ws = p.ws;
    const bf16_t* PROJ = (const bf16_t*)(ws + WS_H); bf16_t* Y = (bf16_t*)(ws + WS_Y);
    const int T = samp ? DSEQ : SEQ;
    const size_t row0 = samp ? (size_t)MP + (size_t)b * DSEQ : (size_t)b * SEQ;
    bf16_t* WA = (bf16_t*)(lds + L_WA); bf16_t* WX = (bf16_t*)(lds + L_WX);
    float* U = (float*)(lds + L_U); float* UC = (float*)(lds + L_UC); bf16_t* UCB = (bf16_t*)(lds + L_UCB);
    float* A = (float*)(lds + L_A); float* BT = (float*)(lds + L_BT); float* SEGA = (float*)(lds + L_SEGA); float* SEGB = (float*)(lds + L_SEGB); float* CW = (float*)(lds + L_CW);
    bf16_t* GL = (bf16_t*)(lds + L_GL);
    const int tr = tid >> 3, c8 = (tid & 7) * 8;
    u32x4 upre = {0u, 0u, 0u, 0u}, gpre = {0u, 0u, 0u, 0u};
    if (tr < T) { const bf16_t* src = PROJ + (row0 + tr) * INC + n * 64 + c8; upre = *(const u32x4*)src; gpre = *(const u32x4*)(src + LW); }
    __syncthreads();
    {
        const int c = tid >> 3, d8 = (tid & 7) * 8;
        const float* wa = p.in[10] + ((size_t)n * 64 + c) * 64 + d8; const float* wx = p.in[12] + ((size_t)n * 64 + c) * 64 + d8;
        const f32x4 a0 = *(const f32x4*)wa, a1 = *(const f32x4*)(wa + 4), x0 = *(const f32x4*)wx, x1 = *(const f32x4*)(wx + 4);
        const float av[8] = {a0.x, a0.y, a0.z, a0.w, a1.x, a1.y, a1.z, a1.w}; const float xv[8] = {x0.x, x0.y, x0.z, x0.w, x1.x, x1.y, x1.z, x1.w};
#pragma unroll
        for (int j = 0; j < 8; ++j) { WA[(d8 + j) * 72 + c] = (bf16_t)(pk2(av[j], 0.f) & 0xffffu); WX[(d8 + j) * 72 + c] = (bf16_t)(pk2(xv[j], 0.f) & 0xffffu); }
        if (tid < 256) CW[tid] = p.in[8][(size_t)(tid >> 6) * LW + n * 64 + (tid & 63)];
        else if (tid < 320) CW[tid] = p.in[9][n * 64 + (tid & 63)];
        if (tid < 192) U[tid] = samp ? p.in[2][((size_t)b * 3 + (tid >> 6)) * LW + n * 64 + (tid & 63)] : 0.f;
    }
    const int mt = w & 3, nh = w >> 2;
    float cba[2], cbx[2], cL[2];
#pragma unroll
    for (int ni = 0; ni < 2; ++ni) { const int d = n * 64 + 32 * nh + 16 * ni + fr; cba[ni] = p.in[11][d]; cbx[ni] = p.in[13][d];
        const float lam = p.in[14][d]; cL[ni] = -8.0f * log1pf(expf(-lam)) * LOG2E; }
    float Hreg = samp ? p.in[3][(size_t)b * LW + n * 64 + lane] : 0.f;
    float hlast = 0.f;
    for (int t0 = 0; t0 < T; t0 += 64) {
        const int tv = (T - t0) < 64 ? (T - t0) : 64;
        { float* dst = U + (3 + tr) * 64 + c8;
          *(f32x4*)dst = (f32x4){__uint_as_float(upre.x << 16), __uint_as_float(upre.x & 0xffff0000u), __uint_as_float(upre.y << 16), __uint_as_float(upre.y & 0xffff0000u)};
          *(f32x4*)(dst + 4) = (f32x4){__uint_as_float(upre.z << 16), __uint_as_float(upre.z & 0xffff0000u), __uint_as_float(upre.w << 16), __uint_as_float(upre.w & 0xffff0000u)};
          *(u32x4*)(GL + tr * 64 + c8) = gpre;
          if (t0 + 64 + tr < T) { const bf16_t* src = PROJ + (row0 + t0 + 64 + tr) * INC + n * 64 + c8; upre = *(const u32x4*)src; gpre = *(const u32x4*)(src + LW); } }
        LDS_BAR();
        { const int t = tr;
          f32x4 o0 = *(const f32x4*)(CW + 256 + c8), o1 = *(const f32x4*)(CW + 256 + c8 + 4);
#pragma unroll
          for (int k = 0; k < 4; ++k) { const f32x4 w0 = *(const f32x4*)(CW + k * 64 + c8), w1 = *(const f32x4*)(CW + k * 64 + c8 + 4);
              const f32x4 u0 = *(const f32x4*)(U + (t + k) * 64 + c8), u1 = *(const f32x4*)(U + (t + k) * 64 + c8 + 4); o0 += w0 * u0; o1 += w1 * u1; }
          *(f32x4*)(UC + t * FS + c8) = o0; *(f32x4*)(UC + t * FS + c8 + 4) = o1;
          u32x4 wv; wv.x = pk2(o0.x, o0.y); wv.y = pk2(o0.z, o0.w); wv.z = pk2(o1.x, o1.y); wv.w = pk2(o1.z, o1.w);
          *(u32x4*)(UCB + t * 72 + c8) = wv; }
        LDS_BAR();
        { bf16x8 af[2];
#pragma unroll
          for (int ks = 0; ks < 2; ++ks) af[ks] = *(const bf16x8*)(UCB + (16 * mt + fr) * 72 + 32 * ks + 8 * g);
#pragma unroll
          for (int ni = 0; ni < 2; ++ni) { const int dl = 32 * nh + 16 * ni + fr;
              f32x4 ca = {0.f, 0.f, 0.f, 0.f}, cx = {0.f, 0.f, 0.f, 0.f};
#pragma unroll
              for (int ks = 0; ks < 2; ++ks) { const bf16x8 ba = *(const bf16x8*)(WA + dl * 72 + 32 * ks + 8 * g), bx = *(const bf16x8*)(WX + dl * 72 + 32 * ks + 8 * g);
                  ca = __builtin_amdgcn_mfma_f32_16x16x32_bf16(af[ks], ba, ca, 0, 0, 0); cx = __builtin_amdgcn_mfma_f32_16x16x32_bf16(af[ks], bx, cx, 0, 0, 0); }
#pragma unroll
              for (int r = 0; r < 4; ++r) { const int t = 16 * mt + 4 * g + r;
                  const float rr = fast_sigmoid(ca[r] + cba[ni]), ii = fast_sigmoid(cx[r] + cbx[ni]);
                  const float a = __builtin_amdgcn_exp2f(rr * cL[ni]);
                  const float gain = sqrtf(fmaxf(1.0f - a * a, 0.f));
                  A[t * FS + dl] = a; BT[t * FS + dl] = gain * ii * UC[t * FS + dl]; } } }
        float ucarry = 0.f; if (tid < 192) ucarry = U[(64 + (tid >> 6)) * 64 + (tid & 63)];
        LDS_BAR();
        if (tid < 192) U[tid] = ucarry;
        float hloc[8], cum[8];
        { float hl = 0.f, ca = 1.f;
#pragma unroll
          for (int s = 0; s < 8; ++s) { const int t = 8 * w + s; const float a = A[t * FS + lane], bb = BT[t * FS + lane]; hl = a * hl + bb; ca *= a; hloc[s] = hl; cum[s] = ca; }
          SEGA[w * 64 + lane] = ca; SEGB[w * 64 + lane] = hl; }
        LDS_BAR();
        { float hcur = Hreg, hin = 0.f; const int lastseg = (tv >> 3) - 1;
#pragma unroll
          for (int s = 0; s < 8; ++s) { if (s == w) hin = hcur; hcur = SEGA[s * 64 + lane] * hcur + SEGB[s * 64 + lane]; if (s == lastseg) hlast = hcur; }
          Hreg = hcur;
#pragma unroll
          for (int s = 0; s < 8; ++s) UC[(8 * w + s) * FS + lane] = hloc[s] + cum[s] * hin; }
        LDS_BAR();
        { const f32x4 h0 = *(const f32x4*)(UC + tr * FS + c8), h1 = *(const f32x4*)(UC + tr * FS + c8 + 4);
          const u32x4 gr = *(const u32x4*)(GL + tr * 64 + c8);
          const float y0 = gelu_tanh(__uint_as_float(gr.x << 16)) * h0.x, y1 = gelu_tanh(__uint_as_float(gr.x & 0xffff0000u)) * h0.y;
          const float y2 = gelu_tanh(__uint_as_float(gr.y << 16)) * h0.z, y3 = gelu_tanh(__uint_as_float(gr.y & 0xffff0000u)) * h0.w;
          const float y4 = gelu_tanh(__uint_as_float(gr.z << 16)) * h1.x, y5 = gelu_tanh(__uint_as_float(gr.z & 0xffff0000u)) * h1.y;
          const float y6 = gelu_tanh(__uint_as_float(gr.w << 16)) * h1.z, y7 = gelu_tanh(__uint_as_float(gr.w & 0xffff0000u)) * h1.w;
          float ss = (y0 * y0 + y1 * y1) + (y2 * y2 + y3 * y3) + (y4 * y4 + y5 * y5) + (y6 * y6 + y7 * y7);
          ss += __shfl_xor(ss, 1); ss += __shfl_xor(ss, 2); ss += __shfl_xor(ss, 4);
          if (tr < tv) { u32x4 wv; wv.x = pk2(y0, y1); wv.y = pk2(y2, y3); wv.z = pk2(y4, y5); wv.w = pk2(y6, y7);
              *(u32x4*)(Y + (row0 + t0 + tr) * DM + n * 64 + c8) = wv;
              if ((tid & 7) == 0) ssqL[(row0 + t0 + tr) * 16 + n] = ss; } }
    }
    if (w == 0) p.out[(samp ? pg8::EO_SLRU : pg8::EO_PLRU) + (size_t)b * LW + n * 64 + lane] = hlast;
}

constexpr int VSTR = 128;
constexpr int A_VT = 0, A_Q = 8 * 64 * VSTR, A_TBL = 2 * A_Q, A_END = A_TBL + 8 * 1280;
struct KVSrc { const bf16_t* k; const bf16_t* v; int stride; int nvalid; };
typedef short v4i16_t __attribute__((ext_vector_type(4)));
__device__ __forceinline__ s16x4 vtr(LAS const unsigned char* pp) { return __builtin_bit_cast(s16x4, __builtin_amdgcn_ds_read_tr16_b64_v4i16((LAS v4i16_t*)(pp))); }

template <int NJ, class Src>
__device__ __forceinline__ void attn_item(LAS unsigned char* vlds, LAS const float* tbl, const bf16_t* Q, int qstride, const Src& src, int jt0, int jt1, bf16_t* O, float* ssq, int lane) {
    const int fr = lane & 15, g = lane >> 4;
    bf16x8 qf[NJ][2];
#pragma unroll
    for (int nj = 0; nj < NJ; ++nj)
#pragma unroll
        for (int ks = 0; ks < 2; ++ks) qf[nj][ks] = *(const bf16x8*)((const char*)(Q + (size_t)(16 * nj) * qstride + 32 * ks) + (unsigned)((fr * qstride + 8 * g) * 2));
    f32x4 Oa[4][NJ]; float mrun[NJ], lsum[NJ];
#pragma unroll
    for (int nj = 0; nj < NJ; ++nj) { mrun[nj] = -INFINITY; lsum[nj] = 0.f;
#pragma unroll
        for (int md = 0; md < 4; ++md) Oa[md][nj] = (f32x4){0.f, 0.f, 0.f, 0.f}; }
    const float c1 = 0.125f * LOG2E;
    int voff[4];
    { const int q = fr >> 2, pp = fr & 3, x = (4 * g + q) & 7;
#pragma unroll
      for (int md = 0; md < 4; ++md) voff[md] = (4 * g + q) * VSTR + (((2 * md + (pp >> 1)) ^ x) * 16) + 8 * (pp & 1); }
    const int dkey = lane >> 3, dch = ((lane & 7) ^ (lane >> 3)) * 8;
    bf16x8 kn[2][2];
    { const KVSrc s = src(jt0); const unsigned klo = (unsigned)((fr * s.stride + 8 * g) * 2), vlo = (unsigned)((dkey * s.stride + dch) * 2);
#pragma unroll
      for (int mi = 0; mi < 2; ++mi) { const char* kb = (const char*)(s.k + (size_t)(16 * mi < s.nvalid ? 16 * mi : 0) * s.stride); kn[mi][0] = *(const bf16x8*)(kb + klo); kn[mi][1] = *(const bf16x8*)(kb + 64 + klo); }
      asm volatile("s_waitcnt lgkmcnt(0)" ::: "memory");
#pragma unroll
      for (int i = 0; i < 4; ++i) { const char* vb = (const char*)(s.v + (size_t)(8 * i < s.nvalid ? 8 * i : 0) * s.stride);
          __builtin_amdgcn_global_load_lds((const unsigned*)(vb + vlo), (LAS unsigned*)(vlds + i * 1024), 16, 0, 0); } }
    for (int jt = jt0; jt < jt1; ++jt) {
        const int buf = (jt - jt0) & 1; const bool more = jt + 1 < jt1;
        const KVSrc s = src(jt);
        bf16x8 kc[2][2];
#pragma unroll
        for (int mi = 0; mi < 2; ++mi) { kc[mi][0] = kn[mi][0]; kc[mi][1] = kn[mi][1]; }
        if (more) {
            const KVSrc sn = src(jt + 1); const unsigned klo = (unsigned)((fr * sn.stride + 8 * g) * 2), vlo = (unsigned)((dkey * sn.stride + dch) * 2);
#pragma unroll
            for (int mi = 0; mi < 2; ++mi) { const char* kb = (const char*)(sn.k + (size_t)(16 * mi < sn.nvalid ? 16 * mi : 0) * sn.stride); kn[mi][0] = *(const bf16x8*)(kb + klo); kn[mi][1] = *(const bf16x8*)(kb + 64 + klo); }
            asm volatile("s_waitcnt lgkmcnt(0)" ::: "memory");
#pragma unroll
            for (int i = 0; i < 4; ++i) { const char* vb = (const char*)(sn.v + (size_t)(8 * i < sn.nvalid ? 8 * i : 0) * sn.stride);
                __builtin_amdgcn_global_load_lds((const unsigned*)(vb + vlo), (LAS unsigned*)(vlds + (buf ^ 1) * 4096 + i * 1024), 16, 0, 0); }
        }
        f32x4 S[2][NJ];
#pragma unroll
        for (int mi = 0; mi < 2; ++mi)
#pragma unroll
            for (int nj = 0; nj < NJ; ++nj) { f32x4 a = {0.f, 0.f, 0.f, 0.f};
                a = __builtin_amdgcn_mfma_f32_16x16x32_bf16(kc[mi][0], qf[nj][0], a, 0, 0, 0); a = __builtin_amdgcn_mfma_f32_16x16x32_bf16(kc[mi][1], qf[nj][1], a, 0, 0, 0); S[mi][nj] = a; }
        if (jt <= 11) { const float bc = tbl[256];
#pragma unroll
            for (int mi = 0; mi < 2; ++mi)
#pragma unroll
                for (int nj = 0; nj < NJ; ++nj) S[mi][nj] = S[mi][nj] * c1 + bc;
        } else { LAS const float* tb = tbl + (640 - 32 * jt - 64 + fr - 4 * g);
#pragma unroll
            for (int mi = 0; mi < 2; ++mi)
#pragma unroll
                for (int nj = 0; nj < NJ; ++nj)
#pragma unroll
                    for (int r = 0; r < 4; ++r) S[mi][nj][r] = S[mi][nj][r] * c1 + tb[64 + 16 * nj - 16 * mi - r];
        }
        if (s.nvalid < 32) {
#pragma unroll
            for (int mi = 0; mi < 2; ++mi)
#pragma unroll
                for (int nj = 0; nj < NJ; ++nj)
#pragma unroll
                    for (int r = 0; r < 4; ++r) if (16 * mi + 4 * g + r >= s.nvalid) S[mi][nj][r] = -INFINITY;
        }
        float mx[NJ]; bool grow = false;
#pragma unroll
        for (int nj = 0; nj < NJ; ++nj) {
            float m = fmaxf(fmaxf(fmaxf(S[0][nj][0], S[0][nj][1]), fmaxf(S[0][nj][2], S[0][nj][3])), fmaxf(fmaxf(S[1][nj][0], S[1][nj][1]), fmaxf(S[1][nj][2], S[1][nj][3])));
            m = rows_max(m); mx[nj] = m;
            grow = grow || (m > mrun[nj] + 8.0f);
        }
        if (__builtin_amdgcn_ballot_w64(grow) != 0ull) {
#pragma unroll
            for (int nj = 0; nj < NJ; ++nj) { const float mnew = fmaxf(mrun[nj], mx[nj]); const float alpha = __builtin_amdgcn_exp2f(mrun[nj] - mnew); mrun[nj] = mnew; lsum[nj] *= alpha;
#pragma unroll
                for (int md = 0; md < 4; ++md) Oa[md][nj] = Oa[md][nj] * alpha; }
        }
        bf16x8 pf[NJ];
#pragma unroll
        for (int nj = 0; nj < NJ; ++nj) {
            float ps = 0.f;
#pragma unroll
            for (int mi = 0; mi < 2; ++mi)
#pragma unroll
                for (int r = 0; r < 4; ++r) { const float pv = __builtin_amdgcn_exp2f(S[mi][nj][r] - mrun[nj]); S[mi][nj][r] = pv; ps += pv; }
            lsum[nj] += ps;
            u32x4 w; w.x = pk2(S[0][nj][0], S[0][nj][1]); w.y = pk2(S[0][nj][2], S[0][nj][3]); w.z = pk2(S[1][nj][0], S[1][nj][1]); w.w = pk2(S[1][nj][2], S[1][nj][3]);
            pf[nj] = __builtin_bit_cast(bf16x8, w);
        }
        if (more) asm volatile("s_waitcnt vmcnt(8)" ::: "memory"); else asm volatile("s_waitcnt vmcnt(0)" ::: "memory");
        LAS const unsigned char* vb = vlds + buf * 4096;
#pragma unroll
        for (int md = 0; md < 4; ++md) {
            const s16x4 lo = vtr(vb + voff[md]), hi = vtr(vb + voff[md] + 16 * VSTR);
            const bf16x8 vf = {lo[0], lo[1], lo[2], lo[3], hi[0], hi[1], hi[2], hi[3]};
#pragma unroll
            for (int nj = 0; nj < NJ; ++nj) Oa[md][nj] = __builtin_amdgcn_mfma_f32_16x16x32_bf16(vf, pf[nj], Oa[md][nj], 0, 0, 0);
        }
    }
#pragma unroll
    for (int nj = 0; nj < NJ; ++nj) {
        float l = rows_sum(lsum[nj]);
        const float inv = 1.0f / l; float ss = 0.f;
        char* orow = (char*)(O + (size_t)(16 * nj) * DM) + (unsigned)((fr * DM + 4 * g) * 2);
#pragma unroll
        for (int md = 0; md < 4; ++md) { const f32x4 o = Oa[md][nj] * inv; ss += (o[0] * o[0] + o[1] * o[1]) + (o[2] * o[2] + o[3] * o[3]);
            u32x2 w; w.x = pk2(o[0], o[1]); w.y = pk2(o[2], o[3]); *(u32x2*)(orow + 32 * md) = w; }
        ss = rows_sum(ss);
        if (g == 0) ssq[(16 * nj + fr) * 16] = ss;
    }
}

struct SrcPrompt { const bf16_t* kbase; int c;
    __device__ __forceinline__ KVSrc operator()(int jt) const { const bf16_t* k = kbase + ((ptrdiff_t)(c - 8) * 64 + jt * 32) * INC; return KVSrc{k, k + 512, INC, 32}; } };
struct SrcSample { const bf16_t* ck; const bf16_t* cv; const bf16_t* knew;
    __device__ __forceinline__ KVSrc operator()(int jt) const { if (jt < 16) return KVSrc{ck + (size_t)(jt * 32) * 512, cv + (size_t)(jt * 32) * 512, 512, 32}; return KVSrc{knew, knew + 512, INC, 16}; } };

__device__ __forceinline__ void attn_tables(const Params& p, unsigned char* lds, int tid) {
    const int lane = tid & 63, h = __builtin_amdgcn_readfirstlane(tid >> 6);
    LAS float* tbl = (LAS float*)((LAS unsigned char*)lds + A_TBL + h * 1280);
    for (int i = lane; i < 320; i += 64) tbl[i] = p.in[15][h * 257 + (i < 256 ? i : 256)] * LOG2E;
}
__device__ __forceinline__ void attn_wg_item(const Params& p, unsigned char* lds, int tid, int it, float* ssqA) {
    asm volatile("" : "+v"(tid));
    const int lane = tid & 63, h = __builtin_amdgcn_readfirstlane(tid >> 6);
    unsigned char* ws = p.ws;
    const bf16_t* PROJ = (const bf16_t*)(ws + WS_H); bf16_t* Y = (bf16_t*)(ws + WS_Y);
    const bf16_t* CK = (const bf16_t*)(ws + WS_CK); const bf16_t* CV = (const bf16_t*)(ws + WS_CV);
    LAS unsigned char* vlds = (LAS unsigned char*)lds + A_VT + h * 64 * VSTR; LAS float* tbl = (LAS float*)((LAS unsigned char*)lds + A_TBL + h * 1280);
    if (it < NB * 32) {
        const int c = 31 - (it >> 5), b = it & 31;
        const size_t r0 = (size_t)b * SEQ + (size_t)c * 64;
        SrcPrompt src{PROJ + (size_t)b * SEQ * INC + 1536 + 64 * h, c};
        attn_item<4, SrcPrompt>(vlds, tbl, PROJ + r0 * INC + 1024 + 64 * h, INC, src, c >= 8 ? 0 : 2 * (8 - c), 18, Y + r0 * DM + 512 + 64 * h, ssqA + r0 * 16 + 8 + h, lane);
    } else {
        const int b = it - NB * 32; const size_t r0 = (size_t)MP + (size_t)b * DSEQ;
        SrcSample src{CK + (size_t)b * 512 * 512 + 64 * h, CV + (size_t)b * 512 * 512 + 64 * h, PROJ + r0 * INC + 1536 + 64 * h};
        attn_item<1, SrcSample>(vlds, tbl, PROJ + r0 * INC + 1024 + 64 * h, INC, src, 0, 17, Y + r0 * DM + 512 + 64 * h, ssqA + r0 * 16 + 8 + h, lane);
    }
}

__device__ __forceinline__ void final_norm(const Params& p, int tid, int G) {
    const int lane = tid & 63, wave = tid >> 6; const int gw = blockIdx.x * NWAVES + wave, NGW = G * NWAVES;
    const float* ssq2 = (const float*)(p.ws + WS_SSQ2); const f32x4* gn = (const f32x4*)p.in[23] + lane;
    f32x4 gv[4];
#pragma unroll
    for (int j = 0; j < 4; ++j) gv[j] = gn[64 * j];
    const float* part = (const float*)(p.ws + WS_PART);
    for (int m = NGW - 1 - gw; m < MS; m += NGW) {
        f32x4* xr = (f32x4*)(p.out + (size_t)(MP + m) * DM) + lane; f32x4 v[4];
#pragma unroll
        for (int j = 0; j < 4; ++j) v[j] = xr[64 * j];
        for (int ks = 0; ks < 11; ++ks) { const f32x4* pr = (const f32x4*)(part + ((size_t)ks * MS + m) * DM) + lane;
#pragma unroll
            for (int j = 0; j < 4; ++j) v[j] += pr[64 * j]; }
        float s = 0.f;
#pragma unroll
        for (int j = 0; j < 4; ++j) s += (v[j].x * v[j].x + v[j].y * v[j].y) + (v[j].z * v[j].z + v[j].w * v[j].w);
        s = wave_sum(s); const float sc = 1.0f / sqrtf(s * (1.f / DM) + EPS);
#pragma unroll
        for (int j = 0; j < 4; ++j) xr[64 * j] = v[j] * sc * gv[j];
    }
}

#define RLX_AGENT __ATOMIC_RELAXED, __HIP_MEMORY_SCOPE_AGENT
#define XB_TMO      128
#define XB_XCNT(j)  (256  + 64 * (j))
#define XB_XSUB(j)  (1280 + 64 * (j))
#define XB_XGEN(j)  (2304 + 64 * (j))
#define XB_TOP      3328
#define XB_TOPGEN   3392
#define XCD_BAR_WORDS 3456
#define XB_SPIN_CAP (1u << 18)

__device__ __forceinline__ unsigned xb_ld(unsigned* p)              { return __hip_atomic_load(p, __ATOMIC_RELAXED, __HIP_MEMORY_SCOPE_AGENT); }
__device__ __forceinline__ unsigned xb_add(unsigned* p, unsigned v) { return __hip_atomic_fetch_add(p, v, __ATOMIC_RELAXED, __HIP_MEMORY_SCOPE_AGENT); }
__device__ __forceinline__ unsigned xb_xcc_id() { return (unsigned)__builtin_amdgcn_s_getreg((3 << 11) | 20) & 0xFu; }
#define XB_SPIN(cond, bar) do { unsigned _sp = 0; while (cond) { __builtin_amdgcn_s_sleep(1); \
    if ((++_sp & 255u) == 0u) { if (xb_ld(&(bar)[XB_TMO])) break; if (_sp > XB_SPIN_CAP) { atomicAdd(&(bar)[XB_TMO], 1u); break; } } } } while (0)

struct XcdBarrier {
    unsigned* bar; unsigned x;
    volatile LAS unsigned* st;
};

__device__ __forceinline__ XcdBarrier xcd_barrier_post(unsigned* bar, volatile LAS unsigned* st) {
    XcdBarrier b; b.bar = bar; b.x = xb_xcc_id(); b.st = st;
    if (threadIdx.x == 0) (void)xb_add(&bar[XB_XCNT(b.x)], 1u);
    return b;
}
__device__ __forceinline__ void xcd_barrier_complete(unsigned* bar, unsigned x, unsigned& nloc, unsigned& nx) {
    const unsigned G = gridDim.x * gridDim.y * gridDim.z;
    unsigned sum, cnt, mine, sp = 0u;
    for (;;) {
        sum = 0u; cnt = 0u; mine = 0u;
#pragma unroll
        for (unsigned j = 0; j < 16; ++j) { const unsigned c = xb_ld(&bar[XB_XCNT(j)]); sum += c; cnt += (c > 0u) ? 1u : 0u; mine = (j == x) ? c : mine; }
        if (sum == G) break;
        __builtin_amdgcn_s_sleep(1);
        if ((++sp & 255u) == 0u) { if (xb_ld(&bar[XB_TMO])) break; if (sp > XB_SPIN_CAP) { atomicAdd(&bar[XB_TMO], 1u); break; } }
    }
    nloc = mine > 0u ? mine : 1u; nx = cnt > 0u ? cnt : 1u;
}

__device__ __forceinline__ void xcd_barrier(const XcdBarrier& b) {
    asm volatile("s_waitcnt vmcnt(0)" ::: "memory");
    __syncthreads();
    if (threadIdx.x == 0) {
        unsigned* bar = b.bar;
        __builtin_amdgcn_s_waitcnt(0);
        unsigned nloc = b.st[0], nx = b.st[1];
        if (nloc == 0u) { xcd_barrier_complete(bar, b.x, nloc, nx); b.st[0] = nloc; b.st[1] = nx; }
        const unsigned old = xb_add(&bar[XB_XSUB(b.x)], 1u);
        const unsigned gen = old / nloc;
        if (old + 1u == (gen + 1u) * nloc) {
            __builtin_amdgcn_fence(__ATOMIC_RELEASE, "agent");
            asm volatile("s_waitcnt vmcnt(0)" ::: "memory");
            const unsigned og = xb_add(&bar[XB_TOP], 1u);
            const unsigned tg = og / nx;
            if (og + 1u == (tg + 1u) * nx) xb_add(&bar[XB_TOPGEN], 1u);
            else XB_SPIN(xb_ld(&bar[XB_TOPGEN]) == tg, bar);
            __builtin_amdgcn_fence(__ATOMIC_ACQUIRE, "agent");
            xb_add(&bar[XB_XGEN(b.x)], 1u);
            asm volatile("s_waitcnt vmcnt(0)" ::: "memory");
        } else {
            XB_SPIN(xb_ld(&bar[XB_XGEN(b.x)]) == gen, bar);
            __builtin_amdgcn_fence(__ATOMIC_ACQUIRE, "agent");
            asm volatile("s_waitcnt vmcnt(0)" ::: "memory");
        }
    }
    __syncthreads();
}

#ifndef DIS_G1
#define DIS_G1 0
#endif
#ifndef DIS_G2
#define DIS_G2 0
#endif
#ifndef DIS_G3
#define DIS_G3 0
#endif
#ifndef DIS_G4
#define DIS_G4 0
#endif
__global__ void __launch_bounds__(NTHR, 2) mega_fwd(Params p, int ph_lo, int ph_hi) {
    extern __shared__ __attribute__((aligned(16))) unsigned char lds[];
    cg::grid_group grid = cg::this_grid();
    const int tid = threadIdx.x, G = gridDim.x;
    unsigned char* ws = p.ws;
#define IN(k) (ph_lo <= (k) && (k) < ph_hi)
    volatile LAS unsigned* bst = (volatile LAS unsigned*)((LAS unsigned char*)lds + LDS_BYTES - 32);
    if (tid < 2) bst[tid] = 0u;
    __syncthreads();
    XcdBarrier xbar; xbar.bar = (unsigned*)(ws + WS_BAR); xbar.x = 0; xbar.st = bst;
#define SEAM(k) do { if (IN(k) && IN((k) + 1)) { if ((k) == 0) { grid.sync(); xbar = xcd_barrier_post((unsigned*)(ws + WS_BAR), bst); } else xcd_barrier(xbar); } } while (0)
    if (IN(0)) { p0_prologue(p, lds, tid, G); }
    SEAM(0);
#ifndef DIS_GEMM
    if (IN(1) && !DIS_G1) {
        pg8::Gemm g{(const bf16_t*)(ws + WS_XB), (const bf16_t*)(ws + WS_W1), MT, INC, DM}; pg8::StaticOrder S; S.init(MT, INC, G, (int)blockIdx.x);
        pg8::Epi1 E{(bf16_t*)(ws + WS_H), (const float*)(ws + WS_RS1), p.out};
        pg8::gemm_phase<pg8::Epi1, pg8::StaticOrder, PG8_ALIGN, PG8_SP2>((LAS unsigned char*)lds, g, S, E);
        if (G == 256) { p0_weights(p, lds, tid, WI_1, WI_2, 20, 236); p0_cache(p, tid, 20, 236); } else { p0_weights(p, lds, tid, WI_1, WI_2, 0, G); p0_cache(p, tid, 0, G); }
    }
#endif
    SEAM(1);
    if (IN(2)) {
        attn_tables(p, lds, tid);
        LAS unsigned* qslot = (LAS unsigned*)((LAS unsigned char*)lds + LDS_BYTES - 16);
        unsigned* ctr = (unsigned*)(ws + WS_CTR);
        const unsigned xcc = xb_xcc_id() & 7u;
        for (unsigned qo = 0; qo < 8; ++qo) {
            const int q = (int)((xcc + qo) & 7u);
            for (;;) {
                __syncthreads();
                if (tid == 0) *qslot = atomicAdd(ctr + 64 * q, 1u);
                __syncthreads();
                const int it = __builtin_amdgcn_readfirstlane((int)*qslot);
                if (it >= 196) break;
                int aj = -1;
                if (it < 64) { if (it & 1) aj = it >> 1; else { const int j = it >> 1; lru_item(p, lds, tid, q + 8 * (j >> 3), j & 7, false, (float*)(ws + WS_SSQP)); } }
                else if (it < 96) { const int j = it - 64; lru_item(p, lds, tid, q + 8 * (j >> 3), j & 7, true, (float*)(ws + WS_SSQP)); }
                else if (it < 100) attn_wg_item(p, lds, tid, NB * 32 + q + 8 * (it - 96), (float*)(ws + WS_SSQP));
                else aj = 32 + (it - 100);
                if (aj >= 0) attn_wg_item(p, lds, tid, ((aj & 31) << 5) | (q + 8 * (aj >> 5)), (float*)(ws + WS_SSQP));
            }
        }
    }
    SEAM(2);
#ifndef DIS_GEMM
    if (IN(3) && !DIS_G2) {
        pg8::Gemm g{(const bf16_t*)(ws + WS_Y), (const bf16_t*)(ws + WS_W2), MT, DM, DM}; pg8::StaticOrder S; S.init(MT, DM, G, (int)blockIdx.x);
        LAS float* tab = (LAS float*)((LAS unsigned char*)lds + 131072);
        { const f32x4* sp = (const f32x4*)(ws + WS_SSQP); pg8::Unit u;
          for (int i = 0; i < 6; ++i) { if (!S.next(i, u)) break; if (tid < 256) { const int row = u.pm * 256 + tid; const f32x4 l0 = sp[row * 4], l1 = sp[row * 4 + 1], a0 = sp[row * 4 + 2], a1 = sp[row * 4 + 3];
              const float l = (((l0.x + l0.y) + (l0.z + l0.w)) + ((l1.x + l1.y) + (l1.z + l1.w))) * (1.f / 512.f) + EPS, a = (((a0.x + a0.y) + (a0.z + a0.w)) + ((a1.x + a1.y) + (a1.z + a1.w))) * (1.f / 512.f) + EPS;
              tab[(i * 256 + tid) * 2] = sqrtf(a / l); tab[(i * 256 + tid) * 2 + 1] = 1.0f / sqrtf(a); } }
          __syncthreads(); }
        pg8::Epi2 E{p.in[0], p.in[1], p.out, (bf16_t*)(ws + WS_XB), tab, (float*)(ws + WS_SSQ1)};
        pg8::gemm_phase<pg8::Epi2, pg8::StaticOrder, PG8_ALIGN, PG8_SP2>((LAS unsigned char*)lds, g, S, E);
        if (G == 256) p0_weights(p, lds, tid, WI_2, WI_END, 8, 248); else p0_weights(p, lds, tid, WI_2, WI_END, 0, G);
    }
    if (IN(3)) SEAM(3);
    if (IN(4) && !DIS_G3) {
        pg8::Gemm g{(const bf16_t*)(ws + WS_XB), (const bf16_t*)(ws + WS_W3), MT, 2 * DFF, DM}; pg8::StaticOrder S; S.init(MT, 2 * DFF, G, (int)blockIdx.x);
        pg8::Epi3 E{(bf16_t*)(ws + WS_H), (const float*)(ws + WS_SSQ1)};
        pg8::gemm_phase<pg8::Epi3, pg8::StaticOrder, PG8_ALIGN, PG8_SP2>((LAS unsigned char*)lds, g, S, E);
    }
    if (IN(4)) SEAM(4);
    if (IN(5) && !DIS_G4) {
        { pg8::Gemm g{(const bf16_t*)(ws + WS_H), (const bf16_t*)(ws + WS_W4), MP, DM, DFF}; pg8::StaticOrder S; S.init(MP, DM, G, (int)blockIdx.x);
          pg8::Epi4N E{p.out, (const bf16_t*)(ws + WS_XB), p.in[23], (float*)(ws + WS_SLOT), (unsigned*)(ws + WS_PCNT), (LAS unsigned char*)lds + 131072};
          pg8::gemm_phase<pg8::Epi4N, pg8::StaticOrder, PG8_ALIGN, PG8_SP2>((LAS unsigned char*)lds, g, S, E); }
        for (int pc = (int)blockIdx.x; pc < 88; pc += G) { const int ks = pc % 11, un = pc / 11;
          pg8::Gemm g{(const bf16_t*)(ws + WS_H) + ks * 256, (const bf16_t*)(ws + WS_W4) + ks * 256, MT, DM, 256, DFF}; pg8::OneUnit S{256 + un / 4, un % 4};
          pg8::Epi4P E{(float*)(ws + WS_PART) + (size_t)ks * MS * DM};
          pg8::gemm_phase<pg8::Epi4P, pg8::OneUnit, false, PG8_SP2>((LAS unsigned char*)lds, g, S, E); }
    }
#endif
    SEAM(5);
    if (IN(6)) { final_norm(p, tid, G); }
#undef IN
#undef SEAM
}

extern "C" void kernel_launch(void* const* d_in, const int* in_sizes, int n_in, void* d_out, int out_size, void* d_ws, size_t ws_size, hipStream_t stream) {
    static int grid = 0;
    if (grid == 0) {
        if (n_in != 24 || (size_t)out_size != pg8::EO_END || ws_size < WS_END) { fprintf(stderr, "kernel_launch: unexpected shapes: n_in %d out %d ws %zu\n", n_in, out_size, ws_size); grid = -1; return; }
        int dev = 0, cus = 0, per_cu = 0;
        hipGetDevice(&dev); hipDeviceGetAttribute(&cus, hipDeviceAttributeMultiprocessorCount, dev);
        if (hipFuncSetAttribute((const void*)mega_fwd, hipFuncAttributeMaxDynamicSharedMemorySize, LDS_BYTES) != hipSuccess) { fprintf(stderr, "kernel_launch: hipFuncSetAttribute failed\n"); grid = -1; return; }
        if (hipOccupancyMaxActiveBlocksPerMultiprocessor(&per_cu, (const void*)mega_fwd, NTHR, LDS_BYTES) != hipSuccess || per_cu < 1) { fprintf(stderr, "kernel_launch: occupancy query says %d\n", per_cu); per_cu = 1; }
        (void)hipGetLastError();
        grid = cus * 1;
        fprintf(stderr, "kernel_launch: grid %d (cus %d, per_cu %d)\n", grid, cus, per_cu);
    }
    if (grid < 0) return;
    Params p{};
    for (int i = 0; i < 24; ++i) p.in[i] = (const float*)d_in[i];
    p.out = (float*)d_out; p.ws = (unsigned char*)d_ws;
#if defined(MK_MULTI)
    for (int ph = 0; ph < 7; ++ph) { int lo = ph, hi = ph + 1; void* args[] = {&p, &lo, &hi};
        hipError_t e = hipLaunchCooperativeKernel((void*)mega_fwd, dim3(grid), dim3(NTHR), args, LDS_BYTES, stream);
        if (e != hipSuccess) fprintf(stderr, "launch %d failed: %s\n", ph, hipGetErrorString(e)); }
#else
    int lo = 0, hi = 7; void* args[] = {&p, &lo, &hi};
    hipError_t e = hipLaunchCooperativeKernel((void*)mega_fwd, dim3(grid), dim3(NTHR), args, LDS_BYTES, stream);
    if (e != hipSuccess) fprintf(stderr, "cooperative launch failed: %s (grid %d)\n", hipGetErrorString(e), grid);
#endif
}
```

```cpp
#include <hip/hip_runtime.h>
#include <hip/hip_cooperative_groups.h>
#include <cstdio>
#include <cstdint>
#include <cmath>
namespace cg = cooperative_groups;
__device__ __forceinline__ float xr16_max(float m) { auto r = __builtin_amdgcn_permlane16_swap(__float_as_uint(m), __float_as_uint(m), false, false); return fmaxf(__uint_as_float(r[0]), __uint_as_float(r[1])); }
__device__ __forceinline__ float xr32_max(float m) { auto r = __builtin_amdgcn_permlane32_swap(__float_as_uint(m), __float_as_uint(m), false, false); return fmaxf(__uint_as_float(r[0]), __uint_as_float(r[1])); }
__device__ __forceinline__ float xr16_sum(float m) { auto r = __builtin_amdgcn_permlane16_swap(__float_as_uint(m), __float_as_uint(m), false, false); return __uint_as_float(r[0]) + __uint_as_float(r[1]); }
__device__ __forceinline__ float xr32_sum(float m) { auto r = __builtin_amdgcn_permlane32_swap(__float_as_uint(m), __float_as_uint(m), false, false); return __uint_as_float(r[0]) + __uint_as_float(r[1]); }
__device__ __forceinline__ float rows_max(float m) { return xr32_max(xr16_max(m)); }
__device__ __forceinline__ float rows_sum(float m) { return xr32_sum(xr16_sum(m)); }
namespace pg8 {
#define PG8_LAS __attribute__((address_space(3)))
typedef unsigned short bf16_t;
typedef short bf16x8 __attribute__((ext_vector_type(8)));
typedef float f32x4 __attribute__((ext_vector_type(4)));
typedef unsigned u32x4 __attribute__((ext_vector_type(4)));
constexpr int BM = 256, BK = 64, HALF = 128, HTB = HALF * BK * 2  , STAGE_BYTES = 8 * HTB, NXCD = 8, WGM = 8;

__host__ __device__ __forceinline__ int lds_byte(int r, int c) { const int st = (r >> 4) * 2 + (c >> 5), rr = r & 15, cc = c & 31, ob = rr * 64 + cc * 2; return st * 1024 + (ob ^ (((ob >> 9) & 1) << 5)); }
__host__ __device__ __forceinline__ void stage_rc(int b, int& R, int& C) { const int st = b / 1024, sb = b % 1024, swz = sb ^ (((sb >> 9) & 1) << 5); R = (st >> 1) * 16 + swz / 64; C = (st & 1) * 32 + (swz % 64) / 2; }
__host__ __device__ __forceinline__ int perm32(int rho) { const int n = rho >> 4, i = rho & 15; return 8 * (i >> 2) + 4 * n + (i & 3); }

struct Unit { int pm, pn; };
struct Gemm { const bf16_t* A; const bf16_t* Bt; int M, N, K; int ld = 0; };

struct StaticOrder {
    int nM, nN, nwg, G, c;
    __host__ __device__ void init(int M, int N, int G_, int c_) { nM = M / BM; nN = N / BM; nwg = nM * nN; G = G_; c = c_; }
    __host__ __device__ bool next(int i, Unit& u) const {
        const long L = (long)i * G + c; if (L >= nwg) return false;
        int wgid = (int)L; { const int q = nwg / NXCD, r = nwg % NXCD, xcd = wgid % NXCD, off = wgid / NXCD; wgid = (xcd < r ? xcd * (q + 1) : r * (q + 1) + (xcd - r) * q) + off; }
        const int nig = WGM * nN, gid = wgid / nig, fm = gid * WGM, gsz = (nM - fm) < WGM ? (nM - fm) : WGM;
        u.pm = fm + ((wgid % nig) % gsz); u.pn = (wgid % nig) / gsz; return true;
    }
    __device__ __forceinline__ void a_ready(const Unit&) const {}
    __device__ __forceinline__ void done(const Unit&) const {}
};

struct OneUnit {
    int pm, pn;
    __device__ __forceinline__ bool next(int i, Unit& u) const { if (i) return false; u.pm = pm; u.pn = pn; return true; }
    __device__ __forceinline__ void a_ready(const Unit&) const {}
    __device__ __forceinline__ void done(const Unit&) const {}
};
__device__ __forceinline__ unsigned cvt_pk_bf16(float lo, float hi) { unsigned r; asm volatile("v_cvt_pk_bf16_f32 %0, %1, %2" : "=v"(r) : "v"(lo), "v"(hi)); return r; }

constexpr int E_DM = 1024, E_INC = 2560, E_DFF = 2816, E_MP = 65536;
constexpr size_t EO_YS = (size_t)65536 * 1024, EO_PCONV = EO_YS + 512 * 1024, EO_PLRU = EO_PCONV + 32 * 3 * 512, EO_PK = EO_PLRU + 32 * 512, EO_PV = EO_PK + (size_t)32 * 512 * 512,
                 EO_SCONV = EO_PV + (size_t)32 * 512 * 512, EO_SLRU = EO_SCONV + 32 * 3 * 512, EO_SK = EO_SLRU + 32 * 512, EO_SV = EO_SK + 32 * 16 * 512, EO_END = EO_SV + 32 * 16 * 512;
constexpr float E_EPS = 1e-6f;

struct Epi1 {
    static constexpr bool PERM = true, AFTER_DRAIN = false, MIDSCALE = false; static constexpr int MID_T = 0;
    bf16_t* P; const float* rs1; float* out;
    __device__ __forceinline__ void mid(f32x4 (&acc)[2][2][4][2], const Unit& u, int wr, int fr, int ui) const {}
    __device__ __forceinline__ void operator()(const f32x4 (&acc)[2][2][4][2], const Unit& u, int wr, int wc, int fr, int fq, int ui) const {
        const int row0 = u.pm * BM + wr * 64 + fr, colb = u.pn * BM + wc * 32 + 8 * fq;
        const bool samp = u.pm >= 256;
        const bool kv = u.pn >= 6 && (samp || (u.pm & 7) >= 6);
        const bool cv = u.pn < 2 && (samp || (u.pm & 7) == 7);
#pragma unroll
        for (int ai = 0; ai < 2; ++ai)
#pragma unroll
            for (int m = 0; m < 4; ++m) {
                const int row = row0 + ai * HALF + m * 16;
#pragma unroll
                for (int bj = 0; bj < 2; ++bj) {
                    const int col = colb + bj * HALF;
                    const f32x4 v0 = acc[ai][bj][m][0], v1 = acc[ai][bj][m][1];
                    u32x4 w; w.x = cvt_pk_bf16(v0[0], v0[1]); w.y = cvt_pk_bf16(v0[2], v0[3]); w.z = cvt_pk_bf16(v1[0], v1[1]); w.w = cvt_pk_bf16(v1[2], v1[3]);
                    *(u32x4*)(P + (size_t)row * E_INC + col) = w;
                    if (kv) {
                        const bool isv = u.pn >= 8; const int c = col - (isv ? 2048 : 1536);
                        float* dst;
                        if (samp) dst = out + (isv ? EO_SV : EO_SK) + (size_t)(row - E_MP) * 512 + c;
                        else { const int b = row >> 11, t = row & 2047; dst = out + (isv ? EO_PV : EO_PK) + ((size_t)(b * 512 + (t - 1536)) * 512 + c); }
                        *(f32x4*)dst = v0; *(f32x4*)(dst + 4) = v1;
                    }
                    if (cv) {
                        if (samp) { const int b = (row - E_MP) >> 4, t = row & 15; if (t >= 13) { float* dst = out + EO_SCONV + ((size_t)(b * 3 + (t - 13)) * 512 + col); *(f32x4*)dst = v0; *(f32x4*)(dst + 4) = v1; } }
                        else { const int b = row >> 11, t = row & 2047; if (t >= 2045) { float* dst = out + EO_PCONV + ((size_t)(b * 3 + (t - 2045)) * 512 + col); *(f32x4*)dst = v0; *(f32x4*)(dst + 4) = v1; } }
                    }
                }
            }
    }
};

struct Epi2 {
    static constexpr bool PERM = true, AFTER_DRAIN = false, MIDSCALE = true; static constexpr int MID_T = 8;
    const float* xp; const float* xs; float* out; bf16_t* X1B; const PG8_LAS float* tab; float* ssq1;
    __device__ __forceinline__ void mid(f32x4 (&acc)[2][2][4][2], const Unit& u, int wr, int fr, int ui) const {
#pragma unroll
        for (int ai = 0; ai < 2; ++ai)
#pragma unroll
            for (int m = 0; m < 4; ++m) {
                const float rho = tab[(ui * 256 + ai * HALF + wr * 64 + m * 16 + fr) * 2];
#pragma unroll
                for (int bj = 0; bj < 2; ++bj)
#pragma unroll
                    for (int n = 0; n < 2; ++n) acc[ai][bj][m][n] = acc[ai][bj][m][n] * rho;
            }
    }
    __device__ __forceinline__ void operator()(const f32x4 (&acc)[2][2][4][2], const Unit& u, int wr, int wc, int fr, int fq, int ui) const {
        const int row0 = u.pm * BM + wr * 64 + fr, colb = u.pn * BM + wc * 32 + 8 * fq;
        const float* xbase = u.pm >= 256 ? xs - (size_t)E_MP * E_DM : xp;
#pragma unroll
        for (int ai = 0; ai < 2; ++ai)
#pragma unroll
            for (int m = 0; m < 4; ++m) {
                const int row = row0 + ai * HALF + m * 16;
                const float rsa = tab[(ui * 256 + ai * HALF + wr * 64 + m * 16 + fr) * 2 + 1];
                float ss = 0.f;
#pragma unroll
                for (int bj = 0; bj < 2; ++bj) {
                    const size_t off = (size_t)row * E_DM + colb + bj * HALF;
                    const f32x4 x0 = *(const f32x4*)(xbase + off), x1 = *(const f32x4*)(xbase + off + 4);
                    const f32x4 v0 = x0 + acc[ai][bj][m][0] * rsa, v1 = x1 + acc[ai][bj][m][1] * rsa;
                    if (u.pm >= 256) { *(f32x4*)(out + off) = v0; *(f32x4*)(out + off + 4) = v1; }
                    u32x4 w; w.x = cvt_pk_bf16(v0[0], v0[1]); w.y = cvt_pk_bf16(v0[2], v0[3]); w.z = cvt_pk_bf16(v1[0], v1[1]); w.w = cvt_pk_bf16(v1[2], v1[3]);
                    *(u32x4*)(X1B + off) = w;
                    ss += (v0[0] * v0[0] + v0[1] * v0[1]) + (v0[2] * v0[2] + v0[3] * v0[3]) + (v1[0] * v1[0] + v1[1] * v1[1]) + (v1[2] * v1[2] + v1[3] * v1[3]);
                }
                ss = rows_sum(ss);
                if (fq == 0) atomicAdd(ssq1 + row, ss);
            }
    }
};

struct Epi3 {
    static constexpr bool PERM = true, AFTER_DRAIN = false, MIDSCALE = false; static constexpr int MID_T = 0;
    bf16_t* H; const float* ssq1;
    __device__ __forceinline__ void mid(f32x4 (&acc)[2][2][4][2], const Unit& u, int wr, int fr, int ui) const {}
    __device__ __forceinline__ void operator()(const f32x4 (&acc)[2][2][4][2], const Unit& u, int wr, int wc, int fr, int fq, int ui) const {
        const int row0 = u.pm * BM + wr * 64 + fr, col = u.pn * HALF + wc * 32 + 8 * fq;
#pragma unroll
        for (int ai = 0; ai < 2; ++ai)
#pragma unroll
            for (int m = 0; m < 4; ++m) {
                const int row = row0 + ai * HALF + m * 16;
                const float rs = __builtin_amdgcn_rsqf(ssq1[row] * (1.f / 1024.f) + E_EPS);
                float hv[8];
#pragma unroll
                for (int n = 0; n < 2; ++n)
#pragma unroll
                    for (int j = 0; j < 4; ++j) {
                        const float g = acc[ai][0][m][n][j] * rs, up = acc[ai][1][m][n][j] * rs;
                        const float sg = g * __builtin_amdgcn_rcpf(1.0f + __builtin_amdgcn_exp2f(-1.44269504f * g));
                        hv[n * 4 + j] = sg * up;
                    }
                u32x4 w; w.x = cvt_pk_bf16(hv[0], hv[1]); w.y = cvt_pk_bf16(hv[2], hv[3]); w.z = cvt_pk_bf16(hv[4], hv[5]); w.w = cvt_pk_bf16(hv[6], hv[7]);
                *(u32x4*)(H + (size_t)row * E_DFF + col) = w;
            }
    }
};

struct Epi4N {
    static constexpr bool PERM = true, AFTER_DRAIN = false, MIDSCALE = false; static constexpr int MID_T = 0;
    float* out; const bf16_t* X1B; const float* gfin; float* slots; unsigned* cnt; PG8_LAS unsigned char* xl;
    __device__ __forceinline__ void mid(f32x4 (&acc)[2][2][4][2], const Unit& u, int wr, int fr, int ui) const {}
    __device__ __forceinline__ void operator()(const f32x4 (&acc)[2][2][4][2], const Unit& u, int wr, int wc, int fr, int fq, int ui) const {
        const int row0 = u.pm * BM + wr * 64 + fr, colb = u.pn * BM + wc * 32 + 8 * fq;
        PG8_LAS float* P = (PG8_LAS float*)xl; PG8_LAS float* S = (PG8_LAS float*)(xl + 4096);
        int tid_ = threadIdx.x; asm volatile("" : "+v"(tid_)); const int tid = tid_;
        f32x4 v[2][4][2][2];
#pragma unroll
        for (int ai = 0; ai < 2; ++ai)
#pragma unroll
            for (int m = 0; m < 4; ++m) {
                const int row = row0 + ai * HALF + m * 16; float ss = 0.f;
#pragma unroll
                for (int bj = 0; bj < 2; ++bj) {
                    const size_t off = (size_t)row * E_DM + colb + bj * HALF;
                    const u32x4 xb = *(const u32x4*)(X1B + off);
                    const f32x4 v0 = (f32x4){__uint_as_float(xb.x << 16), __uint_as_float(xb.x & 0xffff0000u), __uint_as_float(xb.y << 16), __uint_as_float(xb.y & 0xffff0000u)} + acc[ai][bj][m][0];
                    const f32x4 v1 = (f32x4){__uint_as_float(xb.z << 16), __uint_as_float(xb.z & 0xffff0000u), __uint_as_float(xb.w << 16), __uint_as_float(xb.w & 0xffff0000u)} + acc[ai][bj][m][1];
                    v[ai][m][bj][0] = v0; v[ai][m][bj][1] = v1;
                    ss += (v0[0] * v0[0] + v0[1] * v0[1]) + (v0[2] * v0[2] + v0[3] * v0[3]) + (v1[0] * v1[0] + v1[1] * v1[1]) + (v1[2] * v1[2] + v1[3] * v1[3]);
                }
                ss = rows_sum(ss);
                if (fq == 0) P[(ai * HALF + wr * 64 + m * 16 + fr) * 4 + wc] = ss;
            }
        asm volatile("s_waitcnt lgkmcnt(0)" ::: "memory"); __builtin_amdgcn_s_barrier(); asm volatile("" ::: "memory");
        if (tid < 256) { const float tot = (P[tid * 4] + P[tid * 4 + 1]) + (P[tid * 4 + 2] + P[tid * 4 + 3]);
            __hip_atomic_store(slots + ((size_t)(u.pm * BM + tid)) * 4 + u.pn, tot, __ATOMIC_RELAXED, __HIP_MEMORY_SCOPE_AGENT); }
        asm volatile("s_waitcnt vmcnt(0)" ::: "memory"); __builtin_amdgcn_s_barrier(); asm volatile("" ::: "memory");
        if (tid == 0) {
            __hip_atomic_fetch_add(cnt + 64 * u.pm, 1u, __ATOMIC_RELAXED, __HIP_MEMORY_SCOPE_AGENT);
            unsigned spins = 0; while (__hip_atomic_load(cnt + 64 * u.pm, __ATOMIC_RELAXED, __HIP_MEMORY_SCOPE_AGENT) < 4u && ++spins < (1u << 20)) __builtin_amdgcn_s_sleep(2);
        }
        asm volatile("s_waitcnt vmcnt(0) lgkmcnt(0)" ::: "memory"); __builtin_amdgcn_s_barrier(); asm volatile("" ::: "memory");
        if (tid < 256) { const float* sl = slots + ((size_t)(u.pm * BM + tid)) * 4;
            const float tot = (__hip_atomic_load(sl, __ATOMIC_RELAXED, __HIP_MEMORY_SCOPE_AGENT) + __hip_atomic_load(sl + 1, __ATOMIC_RELAXED, __HIP_MEMORY_SCOPE_AGENT))
                            + (__hip_atomic_load(sl + 2, __ATOMIC_RELAXED, __HIP_MEMORY_SCOPE_AGENT) + __hip_atomic_load(sl + 3, __ATOMIC_RELAXED, __HIP_MEMORY_SCOPE_AGENT));
            S[tid] = __builtin_amdgcn_rsqf(tot * (1.f / 1024.f) + E_EPS); }
        asm volatile("s_waitcnt vmcnt(0) lgkmcnt(0)" ::: "memory"); __builtin_amdgcn_s_barrier(); asm volatile("" ::: "memory");
        f32x4 gg[2][2];
#pragma unroll
        for (int bj = 0; bj < 2; ++bj) { gg[bj][0] = *(const f32x4*)(gfin + colb + bj * HALF); gg[bj][1] = *(const f32x4*)(gfin + colb + bj * HALF + 4); }
#pragma unroll
        for (int ai = 0; ai < 2; ++ai)
#pragma unroll
            for (int m = 0; m < 4; ++m) {
                const int row = row0 + ai * HALF + m * 16; const float rs = S[ai * HALF + wr * 64 + m * 16 + fr];
#pragma unroll
                for (int bj = 0; bj < 2; ++bj) { const size_t off = (size_t)row * E_DM + colb + bj * HALF;
                    *(f32x4*)(out + off) = v[ai][m][bj][0] * rs * gg[bj][0]; *(f32x4*)(out + off + 4) = v[ai][m][bj][1] * rs * gg[bj][1]; }
            }
        asm volatile("s_waitcnt lgkmcnt(0)" ::: "memory"); __builtin_amdgcn_s_barrier(); asm volatile("" ::: "memory");
    }
};

struct Epi4P {
    static constexpr bool PERM = true, AFTER_DRAIN = false, MIDSCALE = false; static constexpr int MID_T = 0;
    float* part;
    __device__ __forceinline__ void mid(f32x4 (&acc)[2][2][4][2], const Unit& u, int wr, int fr, int ui) const {}
    __device__ __forceinline__ void operator()(const f32x4 (&acc)[2][2][4][2], const Unit& u, int wr, int wc, int fr, int fq, int ui) const {
        const int row0 = (u.pm - 256) * BM + wr * 64 + fr, colb = u.pn * BM + wc * 32 + 8 * fq;
#pragma unroll
        for (int ai = 0; ai < 2; ++ai)
#pragma unroll
            for (int m = 0; m < 4; ++m)
#pragma unroll
                for (int bj = 0; bj < 2; ++bj) { float* dst = part + (size_t)(row0 + ai * HALF + m * 16) * E_DM + colb + bj * HALF; *(f32x4*)dst = acc[ai][bj][m][0]; *(f32x4*)(dst + 4) = acc[ai][bj][m][1]; }
    }
};

struct Epi4 {
    static constexpr bool PERM = true, AFTER_DRAIN = false, MIDSCALE = false; static constexpr int MID_T = 0;
    float* out; float* ssq2;
    __device__ __forceinline__ void mid(f32x4 (&acc)[2][2][4][2], const Unit& u, int wr, int fr, int ui) const {}
    __device__ __forceinline__ void operator()(const f32x4 (&acc)[2][2][4][2], const Unit& u, int wr, int wc, int fr, int fq, int ui) const {
        const int row0 = u.pm * BM + wr * 64 + fr, colb = u.pn * BM + wc * 32 + 8 * fq;
#pragma unroll
        for (int ai = 0; ai < 2; ++ai)
#pragma unroll
            for (int m = 0; m < 4; ++m) {
                const int row = row0 + ai * HALF + m * 16;
                float ss = 0.f;
#pragma unroll
                for (int bj = 0; bj < 2; ++bj) {
                    const size_t off = (size_t)row * E_DM + colb + bj * HALF;
                    const f32x4 x0 = *(const f32x4*)(out + off), x1 = *(const f32x4*)(out + off + 4);
                    const f32x4 v0 = x0 + acc[ai][bj][m][0], v1 = x1 + acc[ai][bj][m][1];
                    *(f32x4*)(out + off) = v0; *(f32x4*)(out + off + 4) = v1;
                    ss += (v0[0] * v0[0] + v0[1] * v0[1]) + (v0[2] * v0[2] + v0[3] * v0[3]) + (v1[0] * v1[0] + v1[1] * v1[1]) + (v1[2] * v1[2] + v1[3] * v1[3]);
                }
                ss = rows_sum(ss);
                if (fq == 0) atomicAdd(ssq2 + row, ss);
            }
    }
};

template <class Epi, class Sched, bool ALIGN_EPI = false, bool SP2 = false>
__device__ __forceinline__ void gemm_phase(PG8_LAS unsigned char* lds, const Gemm g, const Sched& S, const Epi& E) {
    const int tid = threadIdx.x, wid = __builtin_amdgcn_readfirstlane(tid >> 6), lane = tid & 63, wr = wid >> 2, wc = wid & 3, fr = lane & 15, fq = lane >> 4;
    const int K = g.ld ? g.ld : g.K, nt = g.K / BK;
    unsigned voffA[2], voffB[2];
#pragma unroll
    for (int i = 0; i < 2; ++i) { int R, C; stage_rc(tid * 16 + i * 8192, R, C); const int Rb = Epi::PERM ? ((R & ~31) + perm32(R & 31)) : R;
        voffA[i] = (unsigned)(R * K + C) * 2u; voffB[i] = (unsigned)(Rb * K + C) * 2u; }
    const size_t kstep = (size_t)(BK * 2);
    const size_t hstep = (size_t)HALF * K * 2;
    const size_t tstep = 2 * hstep;
    const unsigned ldsw = (unsigned)wid * 1024u;
    const int aoff = lds_byte(wr * 64 + fr, fq * 8), boff = lds_byte(wc * 32 + fr, fq * 8);
#define PG8_SA(b, h) (((b) * 2 + (h)) * HTB)
#define PG8_SB(b, h) ((4 + (b) * 2 + (h)) * HTB)
#define PG8_STAGE(bufoff, gbase, voff) do { _Pragma("unroll") for (int _i = 0; _i < 2; ++_i) \
        __builtin_amdgcn_global_load_lds((const unsigned*)((const char*)(gbase) + (voff)[_i]), (PG8_LAS unsigned*)(lds + (bufoff) + ldsw + _i * 8192), 16, 0, 0); } while (0)
#define PG8_LDA(dst, b, h) do { _Pragma("unroll") for (int m = 0; m < 4; ++m) _Pragma("unroll") for (int k = 0; k < 2; ++k) dst[m][k] = *(const PG8_LAS bf16x8*)(lds + PG8_SA(b, h) + aoff + m * 2048 + k * 1024); } while (0)
#define PG8_LDB(dst, b, h) do { _Pragma("unroll") for (int n = 0; n < 2; ++n) _Pragma("unroll") for (int k = 0; k < 2; ++k) dst[n][k] = *(const PG8_LAS bf16x8*)(lds + PG8_SB(b, h) + boff + n * 2048 + k * 1024); } while (0)
#define PG8_MMA(ai, bj, At, Bt) do { __builtin_amdgcn_s_setprio(1); _Pragma("unroll") for (int m = 0; m < 4; ++m) _Pragma("unroll") for (int n = 0; n < 2; ++n) _Pragma("unroll") for (int k = 0; k < 2; ++k) \
        acc[ai][bj][m][n] = __builtin_amdgcn_mfma_f32_16x16x32_bf16(Bt[n][k], At[m][k], acc[ai][bj][m][n], 0, 0, 0); __builtin_amdgcn_s_setprio(0); } while (0)
#define PG8_WAIT_V(n) asm volatile("s_waitcnt vmcnt(" #n ")" ::: "memory")
#define PG8_WAIT_L(n) asm volatile("s_waitcnt lgkmcnt(" #n ")" ::: "memory")
#define PG8_BAR __builtin_amdgcn_s_barrier()
#define PG8_SCHED __builtin_amdgcn_sched_barrier(0)
    Unit cur, nxt; int ui = 0;
    if (!S.next(0, cur)) return;
    f32x4 acc[2][2][4][2];
#pragma unroll
    for (int a = 0; a < 2; ++a)
#pragma unroll
        for (int b = 0; b < 2; ++b)
#pragma unroll
            for (int m = 0; m < 4; ++m)
#pragma unroll
                for (int n = 0; n < 2; ++n) acc[a][b][m][n] = (f32x4){0.f, 0.f, 0.f, 0.f};
    bf16x8 At[4][2], B0[2][2], B1[2][2];
    const char* cA = (const char*)g.A + (size_t)cur.pm * tstep; const char* cB = (const char*)g.Bt + (size_t)cur.pn * tstep;
    S.a_ready(cur);
    if constexpr (SP2) {
        PG8_STAGE(PG8_SB(0, 0), cB, voffB); PG8_STAGE(PG8_SB(0, 1), cB + hstep, voffB); PG8_STAGE(PG8_SA(0, 0), cA, voffA); PG8_STAGE(PG8_SA(0, 1), cA + hstep, voffA);
        if (wr == 1) PG8_BAR;
        PG8_WAIT_V(2); PG8_BAR;
        PG8_STAGE(PG8_SB(1, 0), cB + kstep, voffB); PG8_STAGE(PG8_SA(1, 0), cA + kstep, voffA); PG8_STAGE(PG8_SB(1, 1), cB + hstep + kstep, voffB);
        PG8_WAIT_V(6); PG8_BAR;
    } else {
        PG8_STAGE(PG8_SB(0, 0), cB, voffB); PG8_STAGE(PG8_SA(0, 0), cA, voffA); PG8_STAGE(PG8_SB(0, 1), cB + hstep, voffB); PG8_STAGE(PG8_SA(0, 1), cA + hstep, voffA);
        if (wr == 1) PG8_BAR;
        PG8_WAIT_V(4); PG8_BAR;
        PG8_STAGE(PG8_SB(1, 0), cB + kstep, voffB); PG8_STAGE(PG8_SA(1, 0), cA + kstep, voffA); PG8_STAGE(PG8_SB(1, 1), cB + hstep + kstep, voffB);
        PG8_WAIT_V(6); PG8_BAR;
    }
    for (;;) {
        const bool has_next = S.next(ui + 1, nxt);
        const char* nA = has_next ? (const char*)g.A + (size_t)nxt.pm * tstep : cA; const char* nB = has_next ? (const char*)g.Bt + (size_t)nxt.pn * tstep : cB;
        for (int t = 0; t < nt; t += 2) {
            if constexpr (Epi::MIDSCALE) { if (t == Epi::MID_T) E.mid(acc, cur, wr, fr, ui); }
            const bool last = (t == nt - 2);
            const char* a1 = cA + (size_t)(t + 1) * kstep;
            const char* a2 = last ? nA : cA + (size_t)(t + 2) * kstep; const char* b2 = last ? nB : cB + (size_t)(t + 2) * kstep;
            const char* a3 = a2 + kstep; const char* b3 = b2 + kstep;
            if (last && has_next) S.a_ready(nxt);
            if constexpr (SP2) {
            PG8_LDB(B0, 0, 0); PG8_LDB(B1, 0, 1); PG8_SCHED; PG8_LDA(At, 0, 0); PG8_STAGE(PG8_SA(1, 1), a1 + hstep, voffA);
            PG8_WAIT_V(8); PG8_WAIT_L(0); PG8_BAR; PG8_MMA(0, 0, At, B0); PG8_MMA(0, 1, At, B1); PG8_BAR; PG8_SCHED;
            PG8_LDA(At, 0, 1); PG8_STAGE(PG8_SB(0, 0), b2, voffB); PG8_STAGE(PG8_SB(0, 1), b2 + hstep, voffB); PG8_STAGE(PG8_SA(0, 0), a2, voffA);
            PG8_WAIT_V(8); PG8_WAIT_L(0); PG8_BAR; PG8_MMA(1, 0, At, B0); PG8_MMA(1, 1, At, B1); PG8_BAR; PG8_SCHED;
            PG8_LDB(B0, 1, 0); PG8_LDB(B1, 1, 1); PG8_SCHED; PG8_LDA(At, 1, 0); PG8_STAGE(PG8_SA(0, 1), a2 + hstep, voffA);
            PG8_WAIT_V(8); PG8_WAIT_L(0); PG8_BAR; PG8_MMA(0, 0, At, B0); PG8_MMA(0, 1, At, B1); PG8_BAR; PG8_SCHED;
            PG8_LDA(At, 1, 1); PG8_STAGE(PG8_SB(1, 0), b3, voffB); PG8_STAGE(PG8_SB(1, 1), b3 + hstep, voffB); PG8_STAGE(PG8_SA(1, 0), a3, voffA);
            PG8_WAIT_V(8); PG8_WAIT_L(0); PG8_BAR; PG8_MMA(1, 0, At, B0); PG8_MMA(1, 1, At, B1); PG8_BAR; PG8_SCHED;
            } else {
            PG8_LDB(B0, 0, 0); PG8_SCHED; PG8_LDA(At, 0, 0); PG8_STAGE(PG8_SA(1, 1), a1 + hstep, voffA);
            PG8_WAIT_L(8); PG8_BAR; PG8_WAIT_L(0); PG8_MMA(0, 0, At, B0); PG8_BAR; PG8_SCHED;
            PG8_LDB(B1, 0, 1); PG8_STAGE(PG8_SB(0, 0), b2, voffB);
            PG8_BAR; PG8_WAIT_L(0); PG8_MMA(0, 1, At, B1); PG8_BAR;
            PG8_LDA(At, 0, 1); PG8_STAGE(PG8_SA(0, 0), a2, voffA);
            PG8_BAR; PG8_WAIT_L(0); PG8_MMA(1, 0, At, B0); PG8_BAR; PG8_SCHED;
            PG8_STAGE(PG8_SB(0, 1), b2 + hstep, voffB);
            PG8_WAIT_V(6); PG8_BAR; PG8_MMA(1, 1, At, B1); PG8_BAR;
            PG8_LDB(B0, 1, 0); PG8_SCHED; PG8_LDA(At, 1, 0); PG8_STAGE(PG8_SA(0, 1), a2 + hstep, voffA);
            PG8_WAIT_L(8); PG8_BAR; PG8_WAIT_L(0); PG8_MMA(0, 0, At, B0); PG8_BAR; PG8_SCHED;
            PG8_LDB(B1, 1, 1); PG8_STAGE(PG8_SB(1, 0), b3, voffB);
            PG8_BAR; PG8_WAIT_L(0); PG8_MMA(0, 1, At, B1); PG8_BAR;
            PG8_LDA(At, 1, 1); PG8_STAGE(PG8_SA(1, 0), a3, voffA);
            PG8_BAR; PG8_WAIT_L(0); PG8_MMA(1, 0, At, B0); PG8_BAR; PG8_SCHED;
            PG8_STAGE(PG8_SB(1, 1), b3 + hstep, voffB);
            PG8_WAIT_V(6); PG8_BAR; PG8_MMA(1, 1, At, B1); PG8_BAR;
            }
        }
        if constexpr (ALIGN_EPI) { if (wr == 0) PG8_BAR; }
        if constexpr (!Epi::AFTER_DRAIN) { E(acc, cur, wr, wc, fr, fq, ui); S.done(cur); }
        if (!has_next) break;
#pragma unroll
        for (int a = 0; a < 2; ++a)
#pragma unroll
            for (int b = 0; b < 2; ++b)
#pragma unroll
                for (int m = 0; m < 4; ++m)
#pragma unroll
                    for (int n = 0; n < 2; ++n) acc[a][b][m][n] = (f32x4){0.f, 0.f, 0.f, 0.f};
        cur = nxt; cA = nA; cB = nB; ++ui;
        if constexpr (ALIGN_EPI) { if (wr == 1) PG8_BAR; }
    }
    PG8_WAIT_V(0);
    if constexpr (!ALIGN_EPI) { if (wr == 0) PG8_BAR; }
    PG8_BAR;
    if constexpr (Epi::AFTER_DRAIN) { E.fused(acc, cur, wr, wc, fr, fq, lds, wid, lane); S.done(cur); }
#undef PG8_SA
#undef PG8_SB
#undef PG8_STAGE
#undef PG8_LDA
#undef PG8_LDB
#undef PG8_MMA
#undef PG8_WAIT_V
#undef PG8_WAIT_L
#undef PG8_BAR
#undef PG8_SCHED
}
}

#ifndef PG8_SP2
#define PG8_SP2 true
#endif
#ifndef PG8_ALIGN
#define PG8_ALIGN true
#endif

#define LAS __attribute__((address_space(3)))
typedef unsigned short bf16_t;
typedef short bf16x8 __attribute__((ext_vector_type(8)));
typedef short s16x4 __attribute__((ext_vector_type(4)));
typedef float f32x4 __attribute__((ext_vector_type(4)));
typedef unsigned u32x4 __attribute__((ext_vector_type(4)));
typedef unsigned u32x2 __attribute__((ext_vector_type(2)));

constexpr int NWAVES = 8, NTHR = 512;
constexpr int DM = 1024, SEQ = 2048, NB = 32, DSEQ = 16, LW = 512, NH = 8, HD = 64, DFF = 2816, INC = 2560;
constexpr int MP = NB * SEQ, MS = NB * DSEQ, MT = MP + MS;
constexpr float EPS = 1e-6f, LOG2E = 1.4426950408889634f;
constexpr int LDS_BYTES = 147456;

constexpr size_t MiB = 1u << 20;
constexpr size_t WS_CTR = 3 * (1u << 20);
constexpr size_t WS_PCNT = 3 * (1u << 20) + 131072;
constexpr size_t WS_BAR = 3 * (1u << 20) + 65536;
constexpr size_t WS_SSQL = 0, WS_SSQA = 512 * 1024, WS_SSQ1 = 1024 * 1024, WS_SSQ2 = 1536 * 1024, WS_RS1 = 2 * MiB;
constexpr size_t WS_W1 = 4 * MiB, WS_W2 = 9 * MiB, WS_W3 = 11 * MiB, WS_W4 = 22 * MiB, WS_CK = 28 * MiB, WS_CV = 44 * MiB;
constexpr size_t WS_H = 64 * MiB;
constexpr size_t WS_XB = 420 * MiB;
constexpr size_t WS_Y = 552 * MiB;
constexpr size_t WS_SSQP = 684 * MiB;
constexpr size_t WS_PART = 690 * MiB;
constexpr size_t WS_SLOT = 714 * MiB;
constexpr size_t WS_END = 716 * MiB;

struct Params {
    const float* in[24];
    float* out;
    unsigned char* ws;
};

__device__ __forceinline__ float bf2f(unsigned short b) { return __uint_as_float((unsigned)b << 16); }
__device__ __forceinline__ unsigned pk2(float lo, float hi) { return pg8::cvt_pk_bf16(lo, hi); }
__device__ __forceinline__ float wave_sum(float v) {
#pragma unroll
    for (int o = 1; o < 64; o <<= 1) v += __shfl_xor(v, o);
    return v;
}
__device__ __forceinline__ float fast_sigmoid(float z) { return __builtin_amdgcn_rcpf(1.0f + __builtin_amdgcn_exp2f(-LOG2E * z)); }
__device__ __forceinline__ float gelu_tanh(float x) {
    const float z = 0.7978845608028654f * (x + 0.044715f * x * x * x);
    const float e = __builtin_amdgcn_exp2f(2.0f * LOG2E * z);
    const float th = 1.0f - 2.0f * __builtin_amdgcn_rcpf(e + 1.0f);
    return 0.5f * x * (1.0f + th);
}

__device__ __forceinline__ void p0_transpose_item(const float* W, int K, int N, const float* g0, const float* g1, bf16_t* WT, int dst_row0, int k0, int n0, float* scr, int lane) {
#pragma unroll 8
    for (int i = 0; i < 32; ++i) { const int kk = 2 * i + (lane >> 5); const int k = k0 + kk;
        float sc = 1.f; if (g0) sc = (g1 && k >= 512) ? g1[k - 512] : g0[k];
        scr[kk * 33 + (lane & 31)] = W[(size_t)k * N + n0 + (lane & 31)] * sc; }
    asm volatile("s_waitcnt lgkmcnt(0)" ::: "memory");
    const int c = lane & 7;
#pragma unroll
    for (int j = 0; j < 4; ++j) { const int n = (lane >> 3) + 8 * j; const float* s = scr + (8 * c) * 33 + n;
        u32x4 o; o.x = pk2(s[0 * 33], s[1 * 33]); o.y = pk2(s[2 * 33], s[3 * 33]); o.z = pk2(s[4 * 33], s[5 * 33]); o.w = pk2(s[6 * 33], s[7 * 33]);
        *(u32x4*)(WT + (size_t)(dst_row0 + n0 + n) * K + k0 + 8 * c) = o; }
    asm volatile("s_waitcnt lgkmcnt(0)" ::: "memory");
}

__device__ __forceinline__ void p0_weights(const Params& p, unsigned char* lds, int tid, int lo, int hi, int wg0, int nwg) {
    const int lane = tid & 63, wave = tid >> 6;
    float* scr = (float*)(lds + wave * 16384);
    unsigned char* ws = p.ws;
    bf16_t* W1 = (bf16_t*)(ws + WS_W1); bf16_t* W2 = (bf16_t*)(ws + WS_W2); bf16_t* W3 = (bf16_t*)(ws + WS_W3); bf16_t* W4 = (bf16_t*)(ws + WS_W4);
    constexpr int I1 = 16 * 80, I2 = 16 * 32, I3 = 16 * 88;
    if ((int)blockIdx.x < wg0 || (int)blockIdx.x >= wg0 + nwg) return;
    for (int it = lo + ((int)blockIdx.x - wg0) * NWAVES + wave; it < hi; it += nwg * NWAVES) {
        int r = it;
        if (r < I1) { const int kb = r / 80, nb = r % 80; p0_transpose_item(p.in[7], DM, INC, p.in[6], nullptr, W1, 0, kb * 64, nb * 32, scr, lane); continue; } r -= I1;
        if (r < I2) { const int kb = r / 32, nb = r % 32; p0_transpose_item(p.in[18], DM, DM, p.in[16], p.in[17], W2, 0, kb * 64, nb * 32, scr, lane); continue; } r -= I2;
        if (r < I3) { const int kb = r / 88, nb = r % 88; const int n0 = nb * 32; p0_transpose_item(p.in[20], DM, DFF, p.in[19], nullptr, W3, 256 * (n0 / 128) + (n0 % 128) - n0, kb * 64, n0, scr, lane); continue; } r -= I3;
        if (r < I3) { const int kb = r / 88, nb = r % 88; const int n0 = nb * 32; p0_transpose_item(p.in[21], DM, DFF, p.in[19], nullptr, W3, 256 * (n0 / 128) + 128 + (n0 % 128) - n0, kb * 64, n0, scr, lane); continue; } r -= I3;
        { const int kb = r / 32, nb = r % 32; p0_transpose_item(p.in[22], DFF, DM, nullptr, nullptr, W4, 0, kb * 64, nb * 32, scr, lane); }
    }
}
constexpr int WI_1 = 16 * 80, WI_2 = WI_1 + 16 * 32, WI_END = WI_2 + 2 * 16 * 88 + 44 * 32;
__device__ __forceinline__ void p0_cache(const Params& p, int tid, int wg0, int nwg) {
    if ((int)blockIdx.x < wg0 || (int)blockIdx.x >= wg0 + nwg) return;
    unsigned char* ws = p.ws;
    const int gt = ((int)blockIdx.x - wg0) * NTHR + tid, NGT = nwg * NTHR;
    bf16_t* CK = (bf16_t*)(ws + WS_CK); bf16_t* CV = (bf16_t*)(ws + WS_CV);
    constexpr int NC8 = NB * 512 * 512 / 8;
    for (int i0 = gt; i0 < 2 * NC8; i0 += 4 * NGT) {
        f32x4 a[4], b[4];
#pragma unroll
        for (int u = 0; u < 4; ++u) { const int i = i0 + u * NGT; if (i < 2 * NC8) { const int which = i >= NC8; const int e = (which ? i - NC8 : i);
            const f32x4* src = (const f32x4*)(which ? p.in[5] : p.in[4]) + (size_t)e * 2; a[u] = src[0]; b[u] = src[1]; } }
#pragma unroll
        for (int u = 0; u < 4; ++u) { const int i = i0 + u * NGT; if (i < 2 * NC8) { const int which = i >= NC8; const int e = (which ? i - NC8 : i);
            u32x4 w; w.x = pk2(a[u].x, a[u].y); w.y = pk2(a[u].z, a[u].w); w.z = pk2(b[u].x, b[u].y); w.w = pk2(b[u].z, b[u].w);
            *((u32x4*)(which ? CV : CK) + e) = w; } }
    }
}
__device__ __forceinline__ void p0_prologue(const Params& p, unsigned char* lds, int tid, int G) {
    const int lane = tid & 63, wave = tid >> 6;
    const int gw = blockIdx.x * NWAVES + wave, NGW = G * NWAVES;
    unsigned char* ws = p.ws;
    p0_weights(p, lds, tid, 0, WI_1, 0, G);
    bf16_t* XB = (bf16_t*)(ws + WS_XB); float* rs1 = (float*)(ws + WS_RS1);
    for (int m0 = 4 * gw; m0 < MT; m0 += 4 * NGW) {
        f32x4 v[4][4];
#pragma unroll
        for (int r = 0; r < 4; ++r) { const int m = m0 + r; const float* xrow = m < MP ? p.in[0] + (size_t)m * DM : p.in[1] + (size_t)(m - MP) * DM;
            const f32x4* xr = (const f32x4*)xrow + lane;
#pragma unroll
            for (int j = 0; j < 4; ++j) v[r][j] = xr[64 * j]; }
#pragma unroll
        for (int r = 0; r < 4; ++r) { const int m = m0 + r; float s = 0.f;
#pragma unroll
            for (int j = 0; j < 4; ++j) s += (v[r][j].x * v[r][j].x + v[r][j].y * v[r][j].y) + (v[r][j].z * v[r][j].z + v[r][j].w * v[r][j].w);
            s = wave_sum(s);
            const float rs = __builtin_amdgcn_rsqf(s * (1.f / DM) + EPS);
            u32x2* o8 = (u32x2*)(XB + (size_t)m * DM) + lane;
#pragma unroll
            for (int j = 0; j < 4; ++j) { u32x2 w; w.x = pk2(v[r][j].x * rs, v[r][j].y * rs); w.y = pk2(v[r][j].z * rs, v[r][j].w * rs); o8[64 * j] = w; } }
    }
    const int gt = blockIdx.x * NTHR + tid, NGT = G * NTHR;
    float* z0 = (float*)(ws + WS_SSQL); float* z1 = (float*)(ws + WS_SSQA); float* z2 = (float*)(ws + WS_SSQ1); float* z3 = (float*)(ws + WS_SSQ2);
    for (int i = gt; i < MT; i += NGT) { z2[i] = 0.f; z3[i] = 0.f; }
    if (gt < 8) *((unsigned*)(ws + WS_CTR) + 64 * gt) = 0u;
    for (int i = gt; i < 3456; i += NGT) ((unsigned*)(ws + WS_BAR))[i] = 0u;
    for (int i = gt; i < 256 * 64; i += NGT) ((unsigned*)(ws + WS_PCNT))[i] = 0u;
}

#define LDS_BAR() asm volatile("s_waitcnt lgkmcnt(0)\n\ts_barrier" ::: "memory")
constexpr int L_WA = 0, L_WX = 9216, L_U = 18432, L_UC = 35584, L_UCB = 53248, L_A = 62464, L_BT = 79872, L_SEGA = 97280, L_SEGB = 99328, L_CW = 101376, L_GL = 102656, L_END = 110848;
constexpr int FS = 68;
__device__ __forceinline__ void lru_item(const Params& p, unsigned char* lds, int tid, int b, int n, bool samp, float* ssqL) {
    asm volatile("" : "+v"(tid));
    const int lane = tid & 63, w = tid >> 6, fr = lane & 15, g = lane >> 4;
    unsigned char* ws = p.ws;
    const bf16_t* PROJ = (const bf16_t*)(ws + WS_H); bf16_t* Y = (bf16_t*)(ws + WS_Y);
    const int T = samp ? DSEQ : SEQ;
    const size_t row0 = samp ? (size_t)MP + (size_t)b * DSEQ : (size_t)b * SEQ;
    bf16_t* WA = (bf16_t*)(lds + L_WA); bf16_t* WX = (bf16_t*)(lds + L_WX);
    float* U = (float*)(lds + L_U); float* UC = (float*)(lds + L_UC); bf16_t* UCB = (bf16_t*)(lds + L_UCB);
    float* A = (float*)(lds + L_A); float* BT = (float*)(lds + L_BT); float* SEGA = (float*)(lds + L_SEGA); float* SEGB = (float*)(lds + L_SEGB); float* CW = (float*)(lds + L_CW);
    bf16_t* GL = (bf16_t*)(lds + L_GL);
    const int tr = tid >> 3, c8 = (tid & 7) * 8;
    u32x4 upre = {0u, 0u, 0u, 0u}, gpre = {0u, 0u, 0u, 0u};
    if (tr < T) { const bf16_t* src = PROJ + (row0 + tr) * INC + n * 64 + c8; upre = *(const u32x4*)src; gpre = *(const u32x4*)(src + LW); }
    __syncthreads();
    {
        const int c = tid >> 3, d8 = (tid & 7) * 8;
        const float* wa = p.in[10] + ((size_t)n * 64 + c) * 64 + d8; const float* wx = p.in[12] + ((size_t)n * 64 + c) * 64 + d8;
        const f32x4 a0 = *(const f32x4*)wa, a1 = *(const f32x4*)(wa + 4), x0 = *(const f32x4*)wx, x1 = *(const f32x4*)(wx + 4);
        const float av[8] = {a0.x, a0.y, a0.z, a0.w, a1.x, a1.y, a1.z, a1.w}; const float xv[8] = {x0.x, x0.y, x0.z, x0.w, x1.x, x1.y, x1.z, x1.w};
#pragma unroll
        for (int j = 0; j < 8; ++j) { WA[(d8 + j) * 72 + c] = (bf16_t)(pk2(av[j], 0.f) & 0xffffu); WX[(d8 + j) * 72 + c] = (bf16_t)(pk2(xv[j], 0.f) & 0xffffu); }
        if (tid < 256) CW[tid] = p.in[8][(size_t)(tid >> 6) * LW + n * 64 + (tid & 63)];
        else if (tid < 320) CW[tid] = p.in[9][n * 64 + (tid & 63)];
        if (tid < 192) U[tid] = samp ? p.in[2][((size_t)b * 3 + (tid >> 6)) * LW + n * 64 + (tid & 63)] : 0.f;
    }
    const int mt = w & 3, nh = w >> 2;
    float cba[2], cbx[2], cL[2];
#pragma unroll
    for (int ni = 0; ni < 2; ++ni) { const int d = n * 64 + 32 * nh + 16 * ni + fr; cba[ni] = p.in[11][d]; cbx[ni] = p.in[13][d];
        const float lam = p.in[14][d]; cL[ni] = -8.0f * log1pf(expf(-lam)) * LOG2E; }
    float Hreg = samp ? p.in[3][(size_t)b * LW + n * 64 + lane] : 0.f;
    float hlast = 0.f;
    for (int t0 = 0; t0 < T; t0 += 64) {
        const int tv = (T - t0) < 64 ? (T - t0) : 64;
        { float* dst = U + (3 + tr) * 64 + c8;
          *(f32x4*)dst = (f32x4){__uint_as_float(upre.x << 16), __uint_as_float(upre.x & 0xffff0000u), __uint_as_float(upre.y << 16), __uint_as_float(upre.y & 0xffff0000u)};
          *(f32x4*)(dst + 4) = (f32x4){__uint_as_float(upre.z << 16), __uint_as_float(upre.z & 0xffff0000u), __uint_as_float(upre.w << 16), __uint_as_float(upre.w & 0xffff0000u)};
          *(u32x4*)(GL + tr * 64 + c8) = gpre;
          if (t0 + 64 + tr < T) { const bf16_t* src = PROJ + (row0 + t0 + 64 + tr) * INC + n * 64 + c8; upre = *(const u32x4*)src; gpre = *(const u32x4*)(src + LW); } }
        LDS_BAR();
        { const int t = tr;
          f32x4 o0 = *(const f32x4*)(CW + 256 + c8), o1 = *(const f32x4*)(CW + 256 + c8 + 4);
#pragma unroll
          for (int k = 0; k < 4; ++k) { const f32x4 w0 = *(const f32x4*)(CW + k * 64 + c8), w1 = *(const f32x4*)(CW + k * 64 + c8 + 4);
              const f32x4 u0 = *(const f32x4*)(U + (t + k) * 64 + c8), u1 = *(const f32x4*)(U + (t + k) * 64 + c8 + 4); o0 += w0 * u0; o1 += w1 * u1; }
          *(f32x4*)(UC + t * FS + c8) = o0; *(f32x4*)(UC + t * FS + c8 + 4) = o1;
          u32x4 wv; wv.x = pk2(o0.x, o0.y); wv.y = pk2(o0.z, o0.w); wv.z = pk2(o1.x, o1.y); wv.w = pk2(o1.z, o1.w);
          *(u32x4*)(UCB + t * 72 + c8) = wv; }
        LDS_BAR();
        { bf16x8 af[2];
#pragma unroll
          for (int ks = 0; ks < 2; ++ks) af[ks] = *(const bf16x8*)(UCB + (16 * mt + fr) * 72 + 32 * ks + 8 * g);
#pragma unroll
          for (int ni = 0; ni < 2; ++ni) { const int dl = 32 * nh + 16 * ni + fr;
              f32x4 ca = {0.f, 0.f, 0.f, 0.f}, cx = {0.f, 0.f, 0.f, 0.f};
#pragma unroll
              for (int ks = 0; ks < 2; ++ks) { const bf16x8 ba = *(const bf16x8*)(WA + dl * 72 + 32 * ks + 8 * g), bx = *(const bf16x8*)(WX + dl * 72 + 32 * ks + 8 * g);
                  ca = __builtin_amdgcn_mfma_f32_16x16x32_bf16(af[ks], ba, ca, 0, 0, 0); cx = __builtin_amdgcn_mfma_f32_16x16x32_bf16(af[ks], bx, cx, 0, 0, 0); }
#pragma unroll
              for (int r = 0; r < 4; ++r) { const int t = 16 * mt + 4 * g + r;
                  const float rr = fast_sigmoid(ca[r] + cba[ni]), ii = fast_sigmoid(cx[r] + cbx[ni]);
                  const float a = __builtin_amdgcn_exp2f(rr * cL[ni]);
                  const float gain = __builtin_amdgcn_sqrtf(fmaxf(1.0f - a * a, 0.f));
                  A[t * FS + dl] = a; BT[t * FS + dl] = gain * ii * UC[t * FS + dl]; } } }
        float ucarry = 0.f; if (tid < 192) ucarry = U[(64 + (tid >> 6)) * 64 + (tid & 63)];
        LDS_BAR();
        if (tid < 192) U[tid] = ucarry;
        float hloc[8], cum[8];
        { float hl = 0.f, ca = 1.f;
#pragma unroll
          for (int s = 0; s < 8; ++s) { const int t = 8 * w + s; const float a = A[t * FS + lane], bb = BT[t * FS + lane]; hl = a * hl + bb; ca *= a; hloc[s] = hl; cum[s] = ca; }
          SEGA[w * 64 + lane] = ca; SEGB[w * 64 + lane] = hl; }
        LDS_BAR();
        { float hcur = Hreg, hin = 0.f; const int lastseg = (tv >> 3) - 1;
#pragma unroll
          for (int s = 0; s < 8; ++s) { if (s == w) hin = hcur; hcur = SEGA[s * 64 + lane] * hcur + SEGB[s * 64 + lane]; if (s == lastseg) hlast = hcur; }
          Hreg = hcur;
#pragma unroll
          for (int s = 0; s < 8; ++s) UC[(8 * w + s) * FS + lane] = hloc[s] + cum[s] * hin; }
        LDS_BAR();
        { const f32x4 h0 = *(const f32x4*)(UC + tr * FS + c8), h1 = *(const f32x4*)(UC + tr * FS + c8 + 4);
          const u32x4 gr = *(const u32x4*)(GL + tr * 64 + c8);
          const float y0 = gelu_tanh(__uint_as_float(gr.x << 16)) * h0.x, y1 = gelu_tanh(__uint_as_float(gr.x & 0xffff0000u)) * h0.y;
          const float y2 = gelu_tanh(__uint_as_float(gr.y << 16)) * h0.z, y3 = gelu_tanh(__uint_as_float(gr.y & 0xffff0000u)) * h0.w;
          const float y4 = gelu_tanh(__uint_as_float(gr.z << 16)) * h1.x, y5 = gelu_tanh(__uint_as_float(gr.z & 0xffff0000u)) * h1.y;
          const float y6 = gelu_tanh(__uint_as_float(gr.w << 16)) * h1.z, y7 = gelu_tanh(__uint_as_float(gr.w & 0xffff0000u)) * h1.w;
          float ss = (y0 * y0 + y1 * y1) + (y2 * y2 + y3 * y3) + (y4 * y4 + y5 * y5) + (y6 * y6 + y7 * y7);
          ss += __shfl_xor(ss, 1); ss += __shfl_xor(ss, 2); ss += __shfl_xor(ss, 4);
          if (tr < tv) { u32x4 wv; wv.x = pk2(y0, y1); wv.y = pk2(y2, y3); wv.z = pk2(y4, y5); wv.w = pk2(y6, y7);
              *(u32x4*)(Y + (row0 + t0 + tr) * DM + n * 64 + c8) = wv;
              if ((tid & 7) == 0) ssqL[(row0 + t0 + tr) * 16 + n] = ss; } }
    }
    if (w == 0) p.out[(samp ? pg8::EO_SLRU : pg8::EO_PLRU) + (size_t)b * LW + n * 64 + lane] = hlast;
}

constexpr int VSTR = 128;
constexpr int A_VT = 0, A_Q = 8 * 64 * VSTR, A_TBL = 2 * A_Q, A_END = A_TBL + 8 * 1280;
struct KVSrc { const bf16_t* k; const bf16_t* v; int stride; int nvalid; };
typedef short v4i16_t __attribute__((ext_vector_type(4)));
__device__ __forceinline__ s16x4 vtr(LAS const unsigned char* pp) { return __builtin_bit_cast(s16x4, __builtin_amdgcn_ds_read_tr16_b64_v4i16((LAS v4i16_t*)(pp))); }

template <int NJ, class Src>
__device__ __forceinline__ void attn_item(LAS unsigned char* vlds, LAS const float* tbl, const bf16_t* Q, int qstride, const Src& src, int jt0, int jt1, bf16_t* O, float* ssq, int lane) {
    const int fr = lane & 15, g = lane >> 4;
    bf16x8 qf[NJ][2];
#pragma unroll
    for (int nj = 0; nj < NJ; ++nj)
#pragma unroll
        for (int ks = 0; ks < 2; ++ks) qf[nj][ks] = *(const bf16x8*)((const char*)(Q + (size_t)(16 * nj) * qstride + 32 * ks) + (unsigned)((fr * qstride + 8 * g) * 2));
    f32x4 Oa[4][NJ]; float mrun[NJ], lsum[NJ];
#pragma unroll
    for (int nj = 0; nj < NJ; ++nj) { mrun[nj] = -INFINITY; lsum[nj] = 0.f;
#pragma unroll
        for (int md = 0; md < 4; ++md) Oa[md][nj] = (f32x4){0.f, 0.f, 0.f, 0.f}; }
    const float c1 = 0.125f * LOG2E;
    int voff[4];
    { const int q = fr >> 2, pp = fr & 3, x = (4 * g + q) & 7;
#pragma unroll
      for (int md = 0; md < 4; ++md) voff[md] = (4 * g + q) * VSTR + (((2 * md + (pp >> 1)) ^ x) * 16) + 8 * (pp & 1); }
    const int dkey = lane >> 3, dch = ((lane & 7) ^ (lane >> 3)) * 8;
    bf16x8 kn[2][2];
    { const KVSrc s = src(jt0); const unsigned klo = (unsigned)((fr * s.stride + 8 * g) * 2), vlo = (unsigned)((dkey * s.stride + dch) * 2);
#pragma unroll
      for (int mi = 0; mi < 2; ++mi) { const char* kb = (const char*)(s.k + (size_t)(16 * mi < s.nvalid ? 16 * mi : 0) * s.stride); kn[mi][0] = *(const bf16x8*)(kb + klo); kn[mi][1] = *(const bf16x8*)(kb + 64 + klo); }
      asm volatile("s_waitcnt lgkmcnt(0)" ::: "memory");
#pragma unroll
      for (int i = 0; i < 4; ++i) { const char* vb = (const char*)(s.v + (size_t)(8 * i < s.nvalid ? 8 * i : 0) * s.stride);
          __builtin_amdgcn_global_load_lds((const unsigned*)(vb + vlo), (LAS unsigned*)(vlds + i * 1024), 16, 0, 0); } }
    for (int jt = jt0; jt < jt1; ++jt) {
        const int buf = (jt - jt0) & 1; const bool more = jt + 1 < jt1;
        const KVSrc s = src(jt);
        bf16x8 kc[2][2];
#pragma unroll
        for (int mi = 0; mi < 2; ++mi) { kc[mi][0] = kn[mi][0]; kc[mi][1] = kn[mi][1]; }
        if (more) {
            const KVSrc sn = src(jt + 1); const unsigned klo = (unsigned)((fr * sn.stride + 8 * g) * 2), vlo = (unsigned)((dkey * sn.stride + dch) * 2);
#pragma unroll
            for (int mi = 0; mi < 2; ++mi) { const char* kb = (const char*)(sn.k + (size_t)(16 * mi < sn.nvalid ? 16 * mi : 0) * sn.stride); kn[mi][0] = *(const bf16x8*)(kb + klo); kn[mi][1] = *(const bf16x8*)(kb + 64 + klo); }
            asm volatile("s_waitcnt lgkmcnt(0)" ::: "memory");
#pragma unroll
            for (int i = 0; i < 4; ++i) { const char* vb = (const char*)(sn.v + (size_t)(8 * i < sn.nvalid ? 8 * i : 0) * sn.stride);
                __builtin_amdgcn_global_load_lds((const unsigned*)(vb + vlo), (LAS unsigned*)(vlds + (buf ^ 1) * 4096 + i * 1024), 16, 0, 0); }
        }
        f32x4 S[2][NJ];
#pragma unroll
        for (int mi = 0; mi < 2; ++mi)
#pragma unroll
            for (int nj = 0; nj < NJ; ++nj) { f32x4 a = {0.f, 0.f, 0.f, 0.f};
                a = __builtin_amdgcn_mfma_f32_16x16x32_bf16(kc[mi][0], qf[nj][0], a, 0, 0, 0); a = __builtin_amdgcn_mfma_f32_16x16x32_bf16(kc[mi][1], qf[nj][1], a, 0, 0, 0); S[mi][nj] = a; }
        if (jt <= 11) { const float bc = tbl[256];
#pragma unroll
            for (int mi = 0; mi < 2; ++mi)
#pragma unroll
                for (int nj = 0; nj < NJ; ++nj) S[mi][nj] = S[mi][nj] * c1 + bc;
        } else { LAS const float* tb = tbl + (640 - 32 * jt - 64 + fr - 4 * g);
#pragma unroll
            for (int mi = 0; mi < 2; ++mi)
#pragma unroll
                for (int nj = 0; nj < NJ; ++nj)
#pragma unroll
                    for (int r = 0; r < 4; ++r) S[mi][nj][r] = S[mi][nj][r] * c1 + tb[64 + 16 * nj - 16 * mi - r];
        }
        if (s.nvalid < 32) {
#pragma unroll
            for (int mi = 0; mi < 2; ++mi)
#pragma unroll
                for (int nj = 0; nj < NJ; ++nj)
#pragma unroll
                    for (int r = 0; r < 4; ++r) if (16 * mi + 4 * g + r >= s.nvalid) S[mi][nj][r] = -INFINITY;
        }
        float mx[NJ]; bool grow = false;
#pragma unroll
        for (int nj = 0; nj < NJ; ++nj) {
            float m = fmaxf(fmaxf(fmaxf(S[0][nj][0], S[0][nj][1]), fmaxf(S[0][nj][2], S[0][nj][3])), fmaxf(fmaxf(S[1][nj][0], S[1][nj][1]), fmaxf(S[1][nj][2], S[1][nj][3])));
            m = rows_max(m); mx[nj] = m;
            grow = grow || (m > mrun[nj] + 8.0f);
        }
        if (__builtin_amdgcn_ballot_w64(grow) != 0ull) {
#pragma unroll
            for (int nj = 0; nj < NJ; ++nj) { const float mnew = fmaxf(mrun[nj], mx[nj]); const float alpha = __builtin_amdgcn_exp2f(mrun[nj] - mnew); mrun[nj] = mnew; lsum[nj] *= alpha;
#pragma unroll
                for (int md = 0; md < 4; ++md) Oa[md][nj] = Oa[md][nj] * alpha; }
        }
        bf16x8 pf[NJ];
#pragma unroll
        for (int nj = 0; nj < NJ; ++nj) {
            float ps = 0.f;
#pragma unroll
            for (int mi = 0; mi < 2; ++mi)
#pragma unroll
                for (int r = 0; r < 4; ++r) { const float pv = __builtin_amdgcn_exp2f(S[mi][nj][r] - mrun[nj]); S[mi][nj][r] = pv; ps += pv; }
            lsum[nj] += ps;
            u32x4 w; w.x = pk2(S[0][nj][0], S[0][nj][1]); w.y = pk2(S[0][nj][2], S[0][nj][3]); w.z = pk2(S[1][nj][0], S[1][nj][1]); w.w = pk2(S[1][nj][2], S[1][nj][3]);
            pf[nj] = __builtin_bit_cast(bf16x8, w);
        }
        if (more) asm volatile("s_waitcnt vmcnt(8)" ::: "memory"); else asm volatile("s_waitcnt vmcnt(0)" ::: "memory");
        LAS const unsigned char* vb = vlds + buf * 4096;
#pragma unroll
        for (int md = 0; md < 4; ++md) {
            const s16x4 lo = vtr(vb + voff[md]), hi = vtr(vb + voff[md] + 16 * VSTR);
            const bf16x8 vf = {lo[0], lo[1], lo[2], lo[3], hi[0], hi[1], hi[2], hi[3]};
#pragma unroll
            for (int nj = 0; nj < NJ; ++nj) Oa[md][nj] = __builtin_amdgcn_mfma_f32_16x16x32_bf16(vf, pf[nj], Oa[md][nj], 0, 0, 0);
        }
    }
#pragma unroll
    for (int nj = 0; nj < NJ; ++nj) {
        float l = rows_sum(lsum[nj]);
        const float inv = __builtin_amdgcn_rcpf(l); float ss = 0.f;
        char* orow = (char*)(O + (size_t)(16 * nj) * DM) + (unsigned)((fr * DM + 4 * g) * 2);
#pragma unroll
        for (int md = 0; md < 4; ++md) { const f32x4 o = Oa[md][nj] * inv; ss += (o[0] * o[0] + o[1] * o[1]) + (o[2] * o[2] + o[3] * o[3]);
            u32x2 w; w.x = pk2(o[0], o[1]); w.y = pk2(o[2], o[3]); *(u32x2*)(orow + 32 * md) = w; }
        ss = rows_sum(ss);
        if (g == 0) ssq[(16 * nj + fr) * 16] = ss;
    }
}

struct SrcPrompt { const bf16_t* kbase; int c;
    __device__ __forceinline__ KVSrc operator()(int jt) const { const bf16_t* k = kbase + ((ptrdiff_t)(c - 8) * 64 + jt * 32) * INC; return KVSrc{k, k + 512, INC, 32}; } };
struct SrcSample { const bf16_t* ck; const bf16_t* cv; const bf16_t* knew;
    __device__ __forceinline__ KVSrc operator()(int jt) const { if (jt < 16) return KVSrc{ck + (size_t)(jt * 32) * 512, cv + (size_t)(jt * 32) * 512, 512, 32}; return KVSrc{knew, knew + 512, INC, 16}; } };

__device__ __forceinline__ void attn_tables(const Params& p, unsigned char* lds, int tid) {
    const int lane = tid & 63, h = __builtin_amdgcn_readfirstlane(tid >> 6);
    LAS float* tbl = (LAS float*)((LAS unsigned char*)lds + A_TBL + h * 1280);
    for (int i = lane; i < 320; i += 64) tbl[i] = p.in[15][h * 257 + (i < 256 ? i : 256)] * LOG2E;
}
__device__ __forceinline__ void attn_wg_item(const Params& p, unsigned char* lds, int tid, int it, float* ssqA) {
    asm volatile("" : "+v"(tid));
    const int lane = tid & 63, h = __builtin_amdgcn_readfirstlane(tid >> 6);
    unsigned char* ws = p.ws;
    const bf16_t* PROJ = (const bf16_t*)(ws + WS_H); bf16_t* Y = (bf16_t*)(ws + WS_Y);
    const bf16_t* CK = (const bf16_t*)(ws + WS_CK); const bf16_t* CV = (const bf16_t*)(ws + WS_CV);
    LAS unsigned char* vlds = (LAS unsigned char*)lds + A_VT + h * 64 * VSTR; LAS float* tbl = (LAS float*)((LAS unsigned char*)lds + A_TBL + h * 1280);
    if (it < NB * 32) {
        const int c = 31 - (it >> 5), b = it & 31;
        const size_t r0 = (size_t)b * SEQ + (size_t)c * 64;
        SrcPrompt src{PROJ + (size_t)b * SEQ * INC + 1536 + 64 * h, c};
        attn_item<4, SrcPrompt>(vlds, tbl, PROJ + r0 * INC + 1024 + 64 * h, INC, src, c >= 8 ? 0 : 2 * (8 - c), 18, Y + r0 * DM + 512 + 64 * h, ssqA + r0 * 16 + 8 + h, lane);
    } else {
        const int b = it - NB * 32; const size_t r0 = (size_t)MP + (size_t)b * DSEQ;
        SrcSample src{CK + (size_t)b * 512 * 512 + 64 * h, CV + (size_t)b * 512 * 512 + 64 * h, PROJ + r0 * INC + 1536 + 64 * h};
        attn_item<1, SrcSample>(vlds, tbl, PROJ + r0 * INC + 1024 + 64 * h, INC, src, 0, 17, Y + r0 * DM + 512 + 64 * h, ssqA + r0 * 16 + 8 + h, lane);
    }
}

__device__ __forceinline__ void final_norm(const Params& p, int tid, int G) {
    const int lane = tid & 63, wave = tid >> 6; const int gw = blockIdx.x * NWAVES + wave, NGW = G * NWAVES;
    const float* ssq2 = (const float*)(p.ws + WS_SSQ2); const f32x4* gn = (const f32x4*)p.in[23] + lane;
    f32x4 gv[4];
#pragma unroll
    for (int j = 0; j < 4; ++j) gv[j] = gn[64 * j];
    const float* part = (const float*)(p.ws + WS_PART);
    for (int m = NGW - 1 - gw; m < MS; m += NGW) {
        f32x4* xr = (f32x4*)(p.out + (size_t)(MP + m) * DM) + lane; f32x4 v[4];
#pragma unroll
        for (int j = 0; j < 4; ++j) v[j] = xr[64 * j];
        for (int ks = 0; ks < 11; ++ks) { const f32x4* pr = (const f32x4*)(part + ((size_t)ks * MS + m) * DM) + lane;
#pragma unroll
            for (int j = 0; j < 4; ++j) v[j] += pr[64 * j]; }
        float s = 0.f;
#pragma unroll
        for (int j = 0; j < 4; ++j) s += (v[j].x * v[j].x + v[j].y * v[j].y) + (v[j].z * v[j].z + v[j].w * v[j].w);
        s = wave_sum(s); const float sc = __builtin_amdgcn_rsqf(s * (1.f / DM) + EPS);
#pragma unroll
        for (int j = 0; j < 4; ++j) xr[64 * j] = v[j] * sc * gv[j];
    }
}

#define RLX_AGENT __ATOMIC_RELAXED, __HIP_MEMORY_SCOPE_AGENT
#define XB_TMO      128
#define XB_XCNT(j)  (256  + 64 * (j))
#define XB_XSUB(j)  (1280 + 64 * (j))
#define XB_XGEN(j)  (2304 + 64 * (j))
#define XB_TOP      3328
#define XB_TOPGEN   3392
#define XCD_BAR_WORDS 3456
#define XB_SPIN_CAP (1u << 18)

__device__ __forceinline__ unsigned xb_ld(unsigned* p)              { return __hip_atomic_load(p, __ATOMIC_RELAXED, __HIP_MEMORY_SCOPE_AGENT); }
__device__ __forceinline__ unsigned xb_add(unsigned* p, unsigned v) { return __hip_atomic_fetch_add(p, v, __ATOMIC_RELAXED, __HIP_MEMORY_SCOPE_AGENT); }
__device__ __forceinline__ unsigned xb_xcc_id() { return (unsigned)__builtin_amdgcn_s_getreg((3 << 11) | 20) & 0xFu; }
#define XB_SPIN(cond, bar) do { unsigned _sp = 0; while (cond) { __builtin_amdgcn_s_sleep(1); \
    if ((++_sp & 255u) == 0u) { if (xb_ld(&(bar)[XB_TMO])) break; if (_sp > XB_SPIN_CAP) { atomicAdd(&(bar)[XB_TMO], 1u); break; } } } } while (0)

struct XcdBarrier {
    unsigned* bar; unsigned x;
    volatile LAS unsigned* st;
};

__device__ __forceinline__ XcdBarrier xcd_barrier_post(unsigned* bar, volatile LAS unsigned* st) {
    XcdBarrier b; b.bar = bar; b.x = xb_xcc_id(); b.st = st;
    if (threadIdx.x == 0) (void)xb_add(&bar[XB_XCNT(b.x)], 1u);
    return b;
}
__device__ __forceinline__ void xcd_barrier_complete(unsigned* bar, unsigned x, unsigned& nloc, unsigned& nx) {
    const unsigned G = gridDim.x * gridDim.y * gridDim.z;
    unsigned sum, cnt, mine, sp = 0u;
    for (;;) {
        sum = 0u; cnt = 0u; mine = 0u;
#pragma unroll
        for (unsigned j = 0; j < 16; ++j) { const unsigned c = xb_ld(&bar[XB_XCNT(j)]); sum += c; cnt += (c > 0u) ? 1u : 0u; mine = (j == x) ? c : mine; }
        if (sum == G) break;
        __builtin_amdgcn_s_sleep(1);
        if ((++sp & 255u) == 0u) { if (xb_ld(&bar[XB_TMO])) break; if (sp > XB_SPIN_CAP) { atomicAdd(&bar[XB_TMO], 1u); break; } }
    }
    nloc = mine > 0u ? mine : 1u; nx = cnt > 0u ? cnt : 1u;
}

__device__ __forceinline__ void xcd_barrier(const XcdBarrier& b) {
    asm volatile("s_waitcnt vmcnt(0)" ::: "memory");
    __syncthreads();
    if (threadIdx.x == 0) {
        unsigned* bar = b.bar;
        __builtin_amdgcn_s_waitcnt(0);
        unsigned nloc = b.st[0], nx = b.st[1];
        if (nloc == 0u) { xcd_barrier_complete(bar, b.x, nloc, nx); b.st[0] = nloc; b.st[1] = nx; }
        const unsigned old = xb_add(&bar[XB_XSUB(b.x)], 1u);
        const unsigned gen = old / nloc;
        if (old + 1u == (gen + 1u) * nloc) {
            __builtin_amdgcn_fence(__ATOMIC_RELEASE, "agent");
            asm volatile("s_waitcnt vmcnt(0)" ::: "memory");
            const unsigned og = xb_add(&bar[XB_TOP], 1u);
            const unsigned tg = og / nx;
            if (og + 1u == (tg + 1u) * nx) xb_add(&bar[XB_TOPGEN], 1u);
            else XB_SPIN(xb_ld(&bar[XB_TOPGEN]) == tg, bar);
            __builtin_amdgcn_fence(__ATOMIC_ACQUIRE, "agent");
            xb_add(&bar[XB_XGEN(b.x)], 1u);
            asm volatile("s_waitcnt vmcnt(0)" ::: "memory");
        } else {
            XB_SPIN(xb_ld(&bar[XB_XGEN(b.x)]) == gen, bar);
            __builtin_amdgcn_fence(__ATOMIC_ACQUIRE, "agent");
            asm volatile("s_waitcnt vmcnt(0)" ::: "memory");
        }
    }
    __syncthreads();
}

#ifndef DIS_G1
#define DIS_G1 0
#endif
#ifndef DIS_G2
#define DIS_G2 0
#endif
#ifndef DIS_G3
#define DIS_G3 0
#endif
#ifndef DIS_G4
#define DIS_G4 0
#endif
__global__ void __launch_bounds__(NTHR, 2) mega_fwd(Params p, int ph_lo, int ph_hi) {
    extern __shared__ __attribute__((aligned(16))) unsigned char lds[];
    cg::grid_group grid = cg::this_grid();
    const int tid = threadIdx.x, G = gridDim.x;
    unsigned char* ws = p.ws;
#define IN(k) (ph_lo <= (k) && (k) < ph_hi)
    volatile LAS unsigned* bst = (volatile LAS unsigned*)((LAS unsigned char*)lds + LDS_BYTES - 32);
    if (tid < 2) bst[tid] = 0u;
    __syncthreads();
    XcdBarrier xbar; xbar.bar = (unsigned*)(ws + WS_BAR); xbar.x = 0; xbar.st = bst;
#define SEAM(k) do { if (IN(k) && IN((k) + 1)) { if ((k) == 0) { grid.sync(); xbar = xcd_barrier_post((unsigned*)(ws + WS_BAR), bst); } else xcd_barrier(xbar); } } while (0)
    if (IN(0)) { p0_prologue(p, lds, tid, G); }
    SEAM(0);
#ifndef DIS_GEMM
    if (IN(1) && !DIS_G1) {
        pg8::Gemm g{(const bf16_t*)(ws + WS_XB), (const bf16_t*)(ws + WS_W1), MT, INC, DM}; pg8::StaticOrder S; S.init(MT, INC, G, (int)blockIdx.x);
        pg8::Epi1 E{(bf16_t*)(ws + WS_H), (const float*)(ws + WS_RS1), p.out};
        pg8::gemm_phase<pg8::Epi1, pg8::StaticOrder, PG8_ALIGN, PG8_SP2>((LAS unsigned char*)lds, g, S, E);
        if (G == 256) { p0_weights(p, lds, tid, WI_1, WI_2, 20, 236); p0_cache(p, tid, 20, 236); } else { p0_weights(p, lds, tid, WI_1, WI_2, 0, G); p0_cache(p, tid, 0, G); }
    }
#endif
    SEAM(1);
    if (IN(2)) {
        attn_tables(p, lds, tid);
        LAS unsigned* qslot = (LAS unsigned*)((LAS unsigned char*)lds + LDS_BYTES - 16);
        unsigned* ctr = (unsigned*)(ws + WS_CTR);
        const unsigned xcc = xb_xcc_id() & 7u;
        for (unsigned qo = 0; qo < 8; ++qo) {
            const int q = (int)((xcc + qo) & 7u);
            for (;;) {
                __syncthreads();
                if (tid == 0) *qslot = atomicAdd(ctr + 64 * q, 1u);
                __syncthreads();
                const int it = __builtin_amdgcn_readfirstlane((int)*qslot);
                if (it >= 196) break;
                int aj = -1;
                if (it < 64) { if (it & 1) aj = it >> 1; else { const int j = it >> 1; lru_item(p, lds, tid, q + 8 * (j >> 3), j & 7, false, (float*)(ws + WS_SSQP)); } }
                else if (it < 96) { const int j = it - 64; lru_item(p, lds, tid, q + 8 * (j >> 3), j & 7, true, (float*)(ws + WS_SSQP)); }
                else if (it < 100) attn_wg_item(p, lds, tid, NB * 32 + q + 8 * (it - 96), (float*)(ws + WS_SSQP));
                else aj = 32 + (it - 100);
                if (aj >= 0) attn_wg_item(p, lds, tid, ((aj & 31) << 5) | (q + 8 * (aj >> 5)), (float*)(ws + WS_SSQP));
            }
        }
    }
    SEAM(2);
#ifndef DIS_GEMM
    if (IN(3) && !DIS_G2) {
        pg8::Gemm g{(const bf16_t*)(ws + WS_Y), (const bf16_t*)(ws + WS_W2), MT, DM, DM}; pg8::StaticOrder S; S.init(MT, DM, G, (int)blockIdx.x);
        LAS float* tab = (LAS float*)((LAS unsigned char*)lds + 131072);
        { const f32x4* sp = (const f32x4*)(ws + WS_SSQP); pg8::Unit u;
          for (int i = 0; i < 6; ++i) { if (!S.next(i, u)) break; if (tid < 256) { const int row = u.pm * 256 + tid; const f32x4 l0 = sp[row * 4], l1 = sp[row * 4 + 1], a0 = sp[row * 4 + 2], a1 = sp[row * 4 + 3];
              const float l = (((l0.x + l0.y) + (l0.z + l0.w)) + ((l1.x + l1.y) + (l1.z + l1.w))) * (1.f / 512.f) + EPS, a = (((a0.x + a0.y) + (a0.z + a0.w)) + ((a1.x + a1.y) + (a1.z + a1.w))) * (1.f / 512.f) + EPS;
              tab[(i * 256 + tid) * 2] = sqrtf(a / l); tab[(i * 256 + tid) * 2 + 1] = __builtin_amdgcn_rsqf(a); } }
          __syncthreads(); }
        pg8::Epi2 E{p.in[0], p.in[1], p.out, (bf16_t*)(ws + WS_XB), tab, (float*)(ws + WS_SSQ1)};
        pg8::gemm_phase<pg8::Epi2, pg8::StaticOrder, PG8_ALIGN, PG8_SP2>((LAS unsigned char*)lds, g, S, E);
        if (G == 256) p0_weights(p, lds, tid, WI_2, WI_END, 8, 248); else p0_weights(p, lds, tid, WI_2, WI_END, 0, G);
    }
    if (IN(3)) SEAM(3);
    if (IN(4) && !DIS_G3) {
        pg8::Gemm g{(const bf16_t*)(ws + WS_XB), (const bf16_t*)(ws + WS_W3), MT, 2 * DFF, DM}; pg8::StaticOrder S; S.init(MT, 2 * DFF, G, (int)blockIdx.x);
        pg8::Epi3 E{(bf16_t*)(ws + WS_H), (const float*)(ws + WS_SSQ1)};
        pg8::gemm_phase<pg8::Epi3, pg8::StaticOrder, PG8_ALIGN, PG8_SP2>((LAS unsigned char*)lds, g, S, E);
    }
    if (IN(4)) SEAM(4);
    if (IN(5) && !DIS_G4) {
        { pg8::Gemm g{(const bf16_t*)(ws + WS_H), (const bf16_t*)(ws + WS_W4), MP, DM, DFF}; pg8::StaticOrder S; S.init(MP, DM, G, (int)blockIdx.x);
          pg8::Epi4N E{p.out, (const bf16_t*)(ws + WS_XB), p.in[23], (float*)(ws + WS_SLOT), (unsigned*)(ws + WS_PCNT), (LAS unsigned char*)lds + 131072};
          pg8::gemm_phase<pg8::Epi4N, pg8::StaticOrder, PG8_ALIGN, PG8_SP2>((LAS unsigned char*)lds, g, S, E); }
        for (int pc = (int)blockIdx.x; pc < 88; pc += G) { const int ks = pc % 11, un = pc / 11;
          pg8::Gemm g{(const bf16_t*)(ws + WS_H) + ks * 256, (const bf16_t*)(ws + WS_W4) + ks * 256, MT, DM, 256, DFF}; pg8::OneUnit S{256 + un / 4, un % 4};
          pg8::Epi4P E{(float*)(ws + WS_PART) + (size_t)ks * MS * DM};
          pg8::gemm_phase<pg8::Epi4P, pg8::OneUnit, false, PG8_SP2>((LAS unsigned char*)lds, g, S, E); }
    }
#endif
    SEAM(5);
    if (IN(6)) { final_norm(p, tid, G); }
#undef IN
#undef SEAM
}

extern "C" void kernel_launch(void* const* d_in, const int* in_sizes, int n_in, void* d_out, int out_size, void* d_ws, size_t ws_size, hipStream_t stream) {
    static int grid = 0;
    if (grid == 0) {
        if (n_in != 24 || (size_t)out_size != pg8::EO_END || ws_size < WS_END) { fprintf(stderr, "kernel_launch: unexpected shapes: n_in %d out %d ws %zu\n", n_in, out_size, ws_size); grid = -1; return; }
        int dev = 0, cus = 0, per_cu = 0;
        hipGetDevice(&dev); hipDeviceGetAttribute(&cus, hipDeviceAttributeMultiprocessorCount, dev);
        if (hipFuncSetAttribute((const void*)mega_fwd, hipFuncAttributeMaxDynamicSharedMemorySize, LDS_BYTES) != hipSuccess) { fprintf(stderr, "kernel_launch: hipFuncSetAttribute failed\n"); grid = -1; return; }
        if (hipOccupancyMaxActiveBlocksPerMultiprocessor(&per_cu, (const void*)mega_fwd, NTHR, LDS_BYTES) != hipSuccess || per_cu < 1) { fprintf(stderr, "kernel_launch: occupancy query says %d\n", per_cu); per_cu = 1; }
        (void)hipGetLastError();
        grid = cus * 1;
        fprintf(stderr, "kernel_launch: grid %d (cus %d, per_cu %d)\n", grid, cus, per_cu);
    }
    if (grid < 0) return;
    Params p{};
    for (int i = 0; i < 24; ++i) p.in[i] = (const float*)d_in[i];
    p.out = (float*)d_out; p.ws = (unsigned char*)d_ws;
#if defined(MK_MULTI)
    for (int ph = 0; ph < 7; ++ph) { int lo = ph, hi = ph + 1; void* args[] = {&p, &lo, &hi};
        hipError_t e = hipLaunchCooperativeKernel((void*)mega_fwd, dim3(grid), dim3(NTHR), args, LDS_BYTES, stream);
        if (e != hipSuccess) fprintf(stderr, "launch %d failed: %s\n", ph, hipGetErrorString(e)); }
#else
    int lo = 0, hi = 7; void* args[] = {&p, &lo, &hi};
    hipError_t e = hipLaunchCooperativeKernel((void*)mega_fwd, dim3(grid), dim3(NTHR), args, LDS_BYTES, stream);
    if (e != hipSuccess) fprintf(stderr, "cooperative launch failed: %s (grid %d)\n", hipGetErrorString(e), grid);
#endif
}
```

```cpp
#include <hip/hip_runtime.h>
#include <hip/hip_cooperative_groups.h>
#include <cstdio>
#include <cstdint>
#include <cmath>
namespace cg = cooperative_groups;
__device__ __forceinline__ float xr16_max(float m) { auto r = __builtin_amdgcn_permlane16_swap(__float_as_uint(m), __float_as_uint(m), false, false); return fmaxf(__uint_as_float(r[0]), __uint_as_float(r[1])); }
__device__ __forceinline__ float xr32_max(float m) { auto r = __builtin_amdgcn_permlane32_swap(__float_as_uint(m), __float_as_uint(m), false, false); return fmaxf(__uint_as_float(r[0]), __uint_as_float(r[1])); }
__device__ __forceinline__ float xr16_sum(float m) { auto r = __builtin_amdgcn_permlane16_swap(__float_as_uint(m), __float_as_uint(m), false, false); return __uint_as_float(r[0]) + __uint_as_float(r[1]); }
__device__ __forceinline__ float xr32_sum(float m) { auto r = __builtin_amdgcn_permlane32_swap(__float_as_uint(m), __float_as_uint(m), false, false); return __uint_as_float(r[0]) + __uint_as_float(r[1]); }
__device__ __forceinline__ float rows_max(float m) { return xr32_max(xr16_max(m)); }
__device__ __forceinline__ float rows_sum(float m) { return xr32_sum(xr16_sum(m)); }
namespace pg8 {
#define PG8_LAS __attribute__((address_space(3)))
typedef unsigned short bf16_t;
typedef short bf16x8 __attribute__((ext_vector_type(8)));
typedef float f32x4 __attribute__((ext_vector_type(4)));
typedef unsigned u32x4 __attribute__((ext_vector_type(4)));
constexpr int BM = 256, BK = 64, HALF = 128, HTB = HALF * BK * 2  , STAGE_BYTES = 8 * HTB, NXCD = 8, WGM = 8;

__host__ __device__ __forceinline__ int lds_byte(int r, int c) { const int st = (r >> 4) * 2 + (c >> 5), rr = r & 15, cc = c & 31, ob = rr * 64 + cc * 2; return st * 1024 + (ob ^ (((ob >> 9) & 1) << 5)); }
__host__ __device__ __forceinline__ void stage_rc(int b, int& R, int& C) { const int st = b / 1024, sb = b % 1024, swz = sb ^ (((sb >> 9) & 1) << 5); R = (st >> 1) * 16 + swz / 64; C = (st & 1) * 32 + (swz % 64) / 2; }
__host__ __device__ __forceinline__ int perm32(int rho) { const int n = rho >> 4, i = rho & 15; return 8 * (i >> 2) + 4 * n + (i & 3); }

struct Unit { int pm, pn; };
struct Gemm { const bf16_t* A; const bf16_t* Bt; int M, N, K; int ld = 0; };

struct StaticOrder {
    int nM, nN, nwg, G, c;
    __host__ __device__ void init(int M, int N, int G_, int c_) { nM = M / BM; nN = N / BM; nwg = nM * nN; G = G_; c = c_; }
    __host__ __device__ bool next(int i, Unit& u) const {
        const long L = (long)i * G + c; if (L >= nwg) return false;
        int wgid = (int)L; { const int q = nwg / NXCD, r = nwg % NXCD, xcd = wgid % NXCD, off = wgid / NXCD; wgid = (xcd < r ? xcd * (q + 1) : r * (q + 1) + (xcd - r) * q) + off; }
        const int nig = WGM * nN, gid = wgid / nig, fm = gid * WGM, gsz = (nM - fm) < WGM ? (nM - fm) : WGM;
        u.pm = fm + ((wgid % nig) % gsz); u.pn = (wgid % nig) / gsz; return true;
    }
    __device__ __forceinline__ void a_ready(const Unit&) const {}
    __device__ __forceinline__ void done(const Unit&) const {}
};

struct OneUnit {
    int pm, pn;
    __device__ __forceinline__ bool next(int i, Unit& u) const { if (i) return false; u.pm = pm; u.pn = pn; return true; }
    __device__ __forceinline__ void a_ready(const Unit&) const {}
    __device__ __forceinline__ void done(const Unit&) const {}
};
__device__ __forceinline__ unsigned cvt_pk_bf16(float lo, float hi) { unsigned r; asm volatile("v_cvt_pk_bf16_f32 %0, %1, %2" : "=v"(r) : "v"(lo), "v"(hi)); return r; }

constexpr int E_DM = 1024, E_INC = 2560, E_DFF = 2816, E_MP = 65536;
constexpr size_t EO_YS = (size_t)65536 * 1024, EO_PCONV = EO_YS + 512 * 1024, EO_PLRU = EO_PCONV + 32 * 3 * 512, EO_PK = EO_PLRU + 32 * 512, EO_PV = EO_PK + (size_t)32 * 512 * 512,
                 EO_SCONV = EO_PV + (size_t)32 * 512 * 512, EO_SLRU = EO_SCONV + 32 * 3 * 512, EO_SK = EO_SLRU + 32 * 512, EO_SV = EO_SK + 32 * 16 * 512, EO_END = EO_SV + 32 * 16 * 512;
constexpr float E_EPS = 1e-6f;

struct Epi1 {
    static constexpr bool PERM = true, AFTER_DRAIN = false, MIDSCALE = false; static constexpr int MID_T = 0;
    bf16_t* P; const float* rs1; float* out;
    __device__ __forceinline__ void mid(f32x4 (&acc)[2][2][4][2], const Unit& u, int wr, int fr, int ui) const {}
    __device__ __forceinline__ void operator()(const f32x4 (&acc)[2][2][4][2], const Unit& u, int wr, int wc, int fr, int fq, int ui) const {
        const int row0 = u.pm * BM + wr * 64 + fr, colb = u.pn * BM + wc * 32 + 8 * fq;
        const bool samp = u.pm >= 256;
        const bool kv = u.pn >= 6 && (samp || (u.pm & 7) >= 6);
        const bool cv = u.pn < 2 && (samp || (u.pm & 7) == 7);
#pragma unroll
        for (int ai = 0; ai < 2; ++ai)
#pragma unroll
            for (int m = 0; m < 4; ++m) {
                const int row = row0 + ai * HALF + m * 16;
#pragma unroll
                for (int bj = 0; bj < 2; ++bj) {
                    const int col = colb + bj * HALF;
                    const f32x4 v0 = acc[ai][bj][m][0], v1 = acc[ai][bj][m][1];
                    u32x4 w; w.x = cvt_pk_bf16(v0[0], v0[1]); w.y = cvt_pk_bf16(v0[2], v0[3]); w.z = cvt_pk_bf16(v1[0], v1[1]); w.w = cvt_pk_bf16(v1[2], v1[3]);
                    *(u32x4*)(P + (size_t)row * E_INC + col) = w;
                    if (kv) {
                        const bool isv = u.pn >= 8; const int c = col - (isv ? 2048 : 1536);
                        float* dst;
                        if (samp) dst = out + (isv ? EO_SV : EO_SK) + (size_t)(row - E_MP) * 512 + c;
                        else { const int b = row >> 11, t = row & 2047; dst = out + (isv ? EO_PV : EO_PK) + ((size_t)(b * 512 + (t - 1536)) * 512 + c); }
                        *(f32x4*)dst = v0; *(f32x4*)(dst + 4) = v1;
                    }
                    if (cv) {
                        if (samp) { const int b = (row - E_MP) >> 4, t = row & 15; if (t >= 13) { float* dst = out + EO_SCONV + ((size_t)(b * 3 + (t - 13)) * 512 + col); *(f32x4*)dst = v0; *(f32x4*)(dst + 4) = v1; } }
                        else { const int b = row >> 11, t = row & 2047; if (t >= 2045) { float* dst = out + EO_PCONV + ((size_t)(b * 3 + (t - 2045)) * 512 + col); *(f32x4*)dst = v0; *(f32x4*)(dst + 4) = v1; } }
                    }
                }
            }
    }
};

struct Epi2 {
    static constexpr bool PERM = true, AFTER_DRAIN = false, MIDSCALE = true; static constexpr int MID_T = 8;
    const float* xp; const float* xs; float* out; bf16_t* X1B; const PG8_LAS float* tab; float* ssq1;
    __device__ __forceinline__ void mid(f32x4 (&acc)[2][2][4][2], const Unit& u, int wr, int fr, int ui) const {
#pragma unroll
        for (int ai = 0; ai < 2; ++ai)
#pragma unroll
            for (int m = 0; m < 4; ++m) {
                const float rho = tab[(ui * 256 + ai * HALF + wr * 64 + m * 16 + fr) * 2];
#pragma unroll
                for (int bj = 0; bj < 2; ++bj)
#pragma unroll
                    for (int n = 0; n < 2; ++n) acc[ai][bj][m][n] = acc[ai][bj][m][n] * rho;
            }
    }
    __device__ __forceinline__ void operator()(const f32x4 (&acc)[2][2][4][2], const Unit& u, int wr, int wc, int fr, int fq, int ui) const {
        const int row0 = u.pm * BM + wr * 64 + fr, colb = u.pn * BM + wc * 32 + 8 * fq;
        const float* xbase = u.pm >= 256 ? xs - (size_t)E_MP * E_DM : xp;
#pragma unroll
        for (int ai = 0; ai < 2; ++ai)
#pragma unroll
            for (int m = 0; m < 4; ++m) {
                const int row = row0 + ai * HALF + m * 16;
                const float rsa = tab[(ui * 256 + ai * HALF + wr * 64 + m * 16 + fr) * 2 + 1];
                float ss = 0.f;
#pragma unroll
                for (int bj = 0; bj < 2; ++bj) {
                    const size_t off = (size_t)row * E_DM + colb + bj * HALF;
                    const f32x4 x0 = *(const f32x4*)(xbase + off), x1 = *(const f32x4*)(xbase + off + 4);
                    const f32x4 v0 = x0 + acc[ai][bj][m][0] * rsa, v1 = x1 + acc[ai][bj][m][1] * rsa;
                    if (u.pm >= 256) { *(f32x4*)(out + off) = v0; *(f32x4*)(out + off + 4) = v1; }
                    u32x4 w; w.x = cvt_pk_bf16(v0[0], v0[1]); w.y = cvt_pk_bf16(v0[2], v0[3]); w.z = cvt_pk_bf16(v1[0], v1[1]); w.w = cvt_pk_bf16(v1[2], v1[3]);
                    *(u32x4*)(X1B + off) = w;
                    ss += (v0[0] * v0[0] + v0[1] * v0[1]) + (v0[2] * v0[2] + v0[3] * v0[3]) + (v1[0] * v1[0] + v1[1] * v1[1]) + (v1[2] * v1[2] + v1[3] * v1[3]);
                }
                ss = rows_sum(ss);
                if (fq == 0) atomicAdd(ssq1 + row, ss);
            }
    }
};

struct Epi3 {
    static constexpr bool PERM = true, AFTER_DRAIN = false, MIDSCALE = false; static constexpr int MID_T = 0;
    bf16_t* H; const float* ssq1;
    __device__ __forceinline__ void mid(f32x4 (&acc)[2][2][4][2], const Unit& u, int wr, int fr, int ui) const {}
    __device__ __forceinline__ void operator()(const f32x4 (&acc)[2][2][4][2], const Unit& u, int wr, int wc, int fr, int fq, int ui) const {
        const int row0 = u.pm * BM + wr * 64 + fr, col = u.pn * HALF + wc * 32 + 8 * fq;
#pragma unroll
        for (int ai = 0; ai < 2; ++ai)
#pragma unroll
            for (int m = 0; m < 4; ++m) {
                const int row = row0 + ai * HALF + m * 16;
                const float rs = __builtin_amdgcn_rsqf(ssq1[row] * (1.f / 1024.f) + E_EPS);
                const float rsc = -1.44269504f * rs, rs2 = rs * rs;
                float hv[8];
#pragma unroll
                for (int n = 0; n < 2; ++n) {
                    const f32x4 G = acc[ai][0][m][n], U = acc[ai][1][m][n];
                    const f32x4 E = G * rsc;
                    f32x4 D = {__builtin_amdgcn_exp2f(E[0]), __builtin_amdgcn_exp2f(E[1]), __builtin_amdgcn_exp2f(E[2]), __builtin_amdgcn_exp2f(E[3])};
                    D = D + 1.0f;
                    const f32x4 R = {__builtin_amdgcn_rcpf(D[0]), __builtin_amdgcn_rcpf(D[1]), __builtin_amdgcn_rcpf(D[2]), __builtin_amdgcn_rcpf(D[3])};
                    const f32x4 Hv = ((G * U) * rs2) * R;
                    hv[n * 4 + 0] = Hv[0]; hv[n * 4 + 1] = Hv[1]; hv[n * 4 + 2] = Hv[2]; hv[n * 4 + 3] = Hv[3];
                }
                u32x4 w; w.x = cvt_pk_bf16(hv[0], hv[1]); w.y = cvt_pk_bf16(hv[2], hv[3]); w.z = cvt_pk_bf16(hv[4], hv[5]); w.w = cvt_pk_bf16(hv[6], hv[7]);
                *(u32x4*)(H + (size_t)row * E_DFF + col) = w;
            }
    }
};

struct Epi4N {
    static constexpr bool PERM = true, AFTER_DRAIN = false, MIDSCALE = false; static constexpr int MID_T = 0;
    float* out; const bf16_t* X1B; const float* gfin; float* slots; unsigned* cnt; PG8_LAS unsigned char* xl;
    __device__ __forceinline__ void mid(f32x4 (&acc)[2][2][4][2], const Unit& u, int wr, int fr, int ui) const {}
    __device__ __forceinline__ void operator()(const f32x4 (&acc)[2][2][4][2], const Unit& u, int wr, int wc, int fr, int fq, int ui) const {
        const int row0 = u.pm * BM + wr * 64 + fr, colb = u.pn * BM + wc * 32 + 8 * fq;
        PG8_LAS float* P = (PG8_LAS float*)xl; PG8_LAS float* S = (PG8_LAS float*)(xl + 4096);
        int tid_ = threadIdx.x; asm volatile("" : "+v"(tid_)); const int tid = tid_;
        f32x4 v[2][4][2][2];
#pragma unroll
        for (int ai = 0; ai < 2; ++ai)
#pragma unroll
            for (int m = 0; m < 4; ++m) {
                const int row = row0 + ai * HALF + m * 16; float ss = 0.f;
#pragma unroll
                for (int bj = 0; bj < 2; ++bj) {
                    const size_t off = (size_t)row * E_DM + colb + bj * HALF;
                    const u32x4 xb = *(const u32x4*)(X1B + off);
                    const f32x4 v0 = (f32x4){__uint_as_float(xb.x << 16), __uint_as_float(xb.x & 0xffff0000u), __uint_as_float(xb.y << 16), __uint_as_float(xb.y & 0xffff0000u)} + acc[ai][bj][m][0];
                    const f32x4 v1 = (f32x4){__uint_as_float(xb.z << 16), __uint_as_float(xb.z & 0xffff0000u), __uint_as_float(xb.w << 16), __uint_as_float(xb.w & 0xffff0000u)} + acc[ai][bj][m][1];
                    v[ai][m][bj][0] = v0; v[ai][m][bj][1] = v1;
                    ss += (v0[0] * v0[0] + v0[1] * v0[1]) + (v0[2] * v0[2] + v0[3] * v0[3]) + (v1[0] * v1[0] + v1[1] * v1[1]) + (v1[2] * v1[2] + v1[3] * v1[3]);
                }
                ss = rows_sum(ss);
                if (fq == 0) P[(ai * HALF + wr * 64 + m * 16 + fr) * 4 + wc] = ss;
            }
        asm volatile("s_waitcnt lgkmcnt(0)" ::: "memory"); __builtin_amdgcn_s_barrier(); asm volatile("" ::: "memory");
        if (tid < 256) { const float tot = (P[tid * 4] + P[tid * 4 + 1]) + (P[tid * 4 + 2] + P[tid * 4 + 3]);
            __hip_atomic_store(slots + ((size_t)(u.pm * BM + tid)) * 4 + u.pn, tot, __ATOMIC_RELAXED, __HIP_MEMORY_SCOPE_AGENT); }
        asm volatile("s_waitcnt vmcnt(0)" ::: "memory"); __builtin_amdgcn_s_barrier(); asm volatile("" ::: "memory");
        if (tid == 0) {
            __hip_atomic_fetch_add(cnt + 64 * u.pm, 1u, __ATOMIC_RELAXED, __HIP_MEMORY_SCOPE_AGENT);
            unsigned spins = 0; while (__hip_atomic_load(cnt + 64 * u.pm, __ATOMIC_RELAXED, __HIP_MEMORY_SCOPE_AGENT) < 4u && ++spins < (1u << 20)) __builtin_amdgcn_s_sleep(2);
        }
        asm volatile("s_waitcnt vmcnt(0) lgkmcnt(0)" ::: "memory"); __builtin_amdgcn_s_barrier(); asm volatile("" ::: "memory");
        if (tid < 256) { const float* sl = slots + ((size_t)(u.pm * BM + tid)) * 4;
            const float tot = (__hip_atomic_load(sl, __ATOMIC_RELAXED, __HIP_MEMORY_SCOPE_AGENT) + __hip_atomic_load(sl + 1, __ATOMIC_RELAXED, __HIP_MEMORY_SCOPE_AGENT))
                            + (__hip_atomic_load(sl + 2, __ATOMIC_RELAXED, __HIP_MEMORY_SCOPE_AGENT) + __hip_atomic_load(sl + 3, __ATOMIC_RELAXED, __HIP_MEMORY_SCOPE_AGENT));
            S[tid] = __builtin_amdgcn_rsqf(tot * (1.f / 1024.f) + E_EPS); }
        asm volatile("s_waitcnt vmcnt(0) lgkmcnt(0)" ::: "memory"); __builtin_amdgcn_s_barrier(); asm volatile("" ::: "memory");
        f32x4 gg[2][2];
#pragma unroll
        for (int bj = 0; bj < 2; ++bj) { gg[bj][0] = *(const f32x4*)(gfin + colb + bj * HALF); gg[bj][1] = *(const f32x4*)(gfin + colb + bj * HALF + 4); }
#pragma unroll
        for (int ai = 0; ai < 2; ++ai)
#pragma unroll
            for (int m = 0; m < 4; ++m) {
                const int row = row0 + ai * HALF + m * 16; const float rs = S[ai * HALF + wr * 64 + m * 16 + fr];
#pragma unroll
                for (int bj = 0; bj < 2; ++bj) { const size_t off = (size_t)row * E_DM + colb + bj * HALF;
                    *(f32x4*)(out + off) = v[ai][m][bj][0] * rs * gg[bj][0]; *(f32x4*)(out + off + 4) = v[ai][m][bj][1] * rs * gg[bj][1]; }
            }
        asm volatile("s_waitcnt lgkmcnt(0)" ::: "memory"); __builtin_amdgcn_s_barrier(); asm volatile("" ::: "memory");
    }
};

struct Epi4P {
    static constexpr bool PERM = true, AFTER_DRAIN = false, MIDSCALE = false; static constexpr int MID_T = 0;
    float* part;
    __device__ __forceinline__ void mid(f32x4 (&acc)[2][2][4][2], const Unit& u, int wr, int fr, int ui) const {}
    __device__ __forceinline__ void operator()(const f32x4 (&acc)[2][2][4][2], const Unit& u, int wr, int wc, int fr, int fq, int ui) const {
        const int row0 = (u.pm - 256) * BM + wr * 64 + fr, colb = u.pn * BM + wc * 32 + 8 * fq;
#pragma unroll
        for (int ai = 0; ai < 2; ++ai)
#pragma unroll
            for (int m = 0; m < 4; ++m)
#pragma unroll
                for (int bj = 0; bj < 2; ++bj) { float* dst = part + (size_t)(row0 + ai * HALF + m * 16) * E_DM + colb + bj * HALF; *(f32x4*)dst = acc[ai][bj][m][0]; *(f32x4*)(dst + 4) = acc[ai][bj][m][1]; }
    }
};

struct Epi4 {
    static constexpr bool PERM = true, AFTER_DRAIN = false, MIDSCALE = false; static constexpr int MID_T = 0;
    float* out; float* ssq2;
    __device__ __forceinline__ void mid(f32x4 (&acc)[2][2][4][2], const Unit& u, int wr, int fr, int ui) const {}
    __device__ __forceinline__ void operator()(const f32x4 (&acc)[2][2][4][2], const Unit& u, int wr, int wc, int fr, int fq, int ui) const {
        const int row0 = u.pm * BM + wr * 64 + fr, colb = u.pn * BM + wc * 32 + 8 * fq;
#pragma unroll
        for (int ai = 0; ai < 2; ++ai)
#pragma unroll
            for (int m = 0; m < 4; ++m) {
                const int row = row0 + ai * HALF + m * 16;
                float ss = 0.f;
#pragma unroll
                for (int bj = 0; bj < 2; ++bj) {
                    const size_t off = (size_t)row * E_DM + colb + bj * HALF;
                    const f32x4 x0 = *(const f32x4*)(out + off), x1 = *(const f32x4*)(out + off + 4);
                    const f32x4 v0 = x0 + acc[ai][bj][m][0], v1 = x1 + acc[ai][bj][m][1];
                    *(f32x4*)(out + off) = v0; *(f32x4*)(out + off + 4) = v1;
                    ss += (v0[0] * v0[0] + v0[1] * v0[1]) + (v0[2] * v0[2] + v0[3] * v0[3]) + (v1[0] * v1[0] + v1[1] * v1[1]) + (v1[2] * v1[2] + v1[3] * v1[3]);
                }
                ss = rows_sum(ss);
                if (fq == 0) atomicAdd(ssq2 + row, ss);
            }
    }
};

template <class Epi, class Sched, bool ALIGN_EPI = false, bool SP2 = false>
__device__ __forceinline__ void gemm_phase(PG8_LAS unsigned char* lds, const Gemm g, const Sched& S, const Epi& E) {
    const int tid = threadIdx.x, wid = __builtin_amdgcn_readfirstlane(tid >> 6), lane = tid & 63, wr = wid >> 2, wc = wid & 3, fr = lane & 15, fq = lane >> 4;
    const int K = g.ld ? g.ld : g.K, nt = g.K / BK;
    unsigned voffA[2], voffB[2];
#pragma unroll
    for (int i = 0; i < 2; ++i) { int R, C; stage_rc(tid * 16 + i * 8192, R, C); const int Rb = Epi::PERM ? ((R & ~31) + perm32(R & 31)) : R;
        voffA[i] = (unsigned)(R * K + C) * 2u; voffB[i] = (unsigned)(Rb * K + C) * 2u; }
    const size_t kstep = (size_t)(BK * 2);
    const size_t hstep = (size_t)HALF * K * 2;
    const size_t tstep = 2 * hstep;
    const unsigned ldsw = (unsigned)wid * 1024u;
    const int aoff = lds_byte(wr * 64 + fr, fq * 8), boff = lds_byte(wc * 32 + fr, fq * 8);
#define PG8_SA(b, h) (((b) * 2 + (h)) * HTB)
#define PG8_SB(b, h) ((4 + (b) * 2 + (h)) * HTB)
#define PG8_STAGE(bufoff, gbase, voff) do { _Pragma("unroll") for (int _i = 0; _i < 2; ++_i) \
        __builtin_amdgcn_global_load_lds((const unsigned*)((const char*)(gbase) + (voff)[_i]), (PG8_LAS unsigned*)(lds + (bufoff) + ldsw + _i * 8192), 16, 0, 0); } while (0)
#define PG8_LDA(dst, b, h) do { _Pragma("unroll") for (int m = 0; m < 4; ++m) _Pragma("unroll") for (int k = 0; k < 2; ++k) dst[m][k] = *(const PG8_LAS bf16x8*)(lds + PG8_SA(b, h) + aoff + m * 2048 + k * 1024); } while (0)
#define PG8_LDB(dst, b, h) do { _Pragma("unroll") for (int n = 0; n < 2; ++n) _Pragma("unroll") for (int k = 0; k < 2; ++k) dst[n][k] = *(const PG8_LAS bf16x8*)(lds + PG8_SB(b, h) + boff + n * 2048 + k * 1024); } while (0)
#define PG8_MMA(ai, bj, At, Bt) do { __builtin_amdgcn_s_setprio(1); _Pragma("unroll") for (int m = 0; m < 4; ++m) _Pragma("unroll") for (int n = 0; n < 2; ++n) _Pragma("unroll") for (int k = 0; k < 2; ++k) \
        acc[ai][bj][m][n] = __builtin_amdgcn_mfma_f32_16x16x32_bf16(Bt[n][k], At[m][k], acc[ai][bj][m][n], 0, 0, 0); __builtin_amdgcn_s_setprio(0); } while (0)
#define PG8_WAIT_V(n) asm volatile("s_waitcnt vmcnt(" #n ")" ::: "memory")
#define PG8_WAIT_L(n) asm volatile("s_waitcnt lgkmcnt(" #n ")" ::: "memory")
#define PG8_BAR __builtin_amdgcn_s_barrier()
#define PG8_SCHED __builtin_amdgcn_sched_barrier(0)
    Unit cur, nxt; int ui = 0;
    if (!S.next(0, cur)) return;
    f32x4 acc[2][2][4][2];
#pragma unroll
    for (int a = 0; a < 2; ++a)
#pragma unroll
        for (int b = 0; b < 2; ++b)
#pragma unroll
            for (int m = 0; m < 4; ++m)
#pragma unroll
                for (int n = 0; n < 2; ++n) acc[a][b][m][n] = (f32x4){0.f, 0.f, 0.f, 0.f};
    bf16x8 At[4][2], B0[2][2], B1[2][2];
    const char* cA = (const char*)g.A + (size_t)cur.pm * tstep; const char* cB = (const char*)g.Bt + (size_t)cur.pn * tstep;
    S.a_ready(cur);
    if constexpr (SP2) {
        PG8_STAGE(PG8_SB(0, 0), cB, voffB); PG8_STAGE(PG8_SB(0, 1), cB + hstep, voffB); PG8_STAGE(PG8_SA(0, 0), cA, voffA); PG8_STAGE(PG8_SA(0, 1), cA + hstep, voffA);
        if (wr == 1) PG8_BAR;
        PG8_WAIT_V(2); PG8_BAR;
        PG8_STAGE(PG8_SB(1, 0), cB + kstep, voffB); PG8_STAGE(PG8_SA(1, 0), cA + kstep, voffA); PG8_STAGE(PG8_SB(1, 1), cB + hstep + kstep, voffB);
        PG8_WAIT_V(6); PG8_BAR;
    } else {
        PG8_STAGE(PG8_SB(0, 0), cB, voffB); PG8_STAGE(PG8_SA(0, 0), cA, voffA); PG8_STAGE(PG8_SB(0, 1), cB + hstep, voffB); PG8_STAGE(PG8_SA(0, 1), cA + hstep, voffA);
        if (wr == 1) PG8_BAR;
        PG8_WAIT_V(4); PG8_BAR;
        PG8_STAGE(PG8_SB(1, 0), cB + kstep, voffB); PG8_STAGE(PG8_SA(1, 0), cA + kstep, voffA); PG8_STAGE(PG8_SB(1, 1), cB + hstep + kstep, voffB);
        PG8_WAIT_V(6); PG8_BAR;
    }
    for (;;) {
        const bool has_next = S.next(ui + 1, nxt);
        const char* nA = has_next ? (const char*)g.A + (size_t)nxt.pm * tstep : cA; const char* nB = has_next ? (const char*)g.Bt + (size_t)nxt.pn * tstep : cB;
        for (int t = 0; t < nt; t += 2) {
            if constexpr (Epi::MIDSCALE) { if (t == Epi::MID_T) E.mid(acc, cur, wr, fr, ui); }
            const bool last = (t == nt - 2);
            const char* a1 = cA + (size_t)(t + 1) * kstep;
            const char* a2 = last ? nA : cA + (size_t)(t + 2) * kstep; const char* b2 = last ? nB : cB + (size_t)(t + 2) * kstep;
            const char* a3 = a2 + kstep; const char* b3 = b2 + kstep;
            if (last && has_next) S.a_ready(nxt);
            if constexpr (SP2) {
            PG8_LDB(B0, 0, 0); PG8_LDB(B1, 0, 1); PG8_SCHED; PG8_LDA(At, 0, 0); PG8_STAGE(PG8_SA(1, 1), a1 + hstep, voffA);
            PG8_WAIT_V(8); PG8_WAIT_L(0); PG8_BAR; PG8_MMA(0, 0, At, B0); PG8_MMA(0, 1, At, B1); PG8_BAR; PG8_SCHED;
            PG8_LDA(At, 0, 1); PG8_STAGE(PG8_SB(0, 0), b2, voffB); PG8_STAGE(PG8_SB(0, 1), b2 + hstep, voffB); PG8_STAGE(PG8_SA(0, 0), a2, voffA);
            PG8_WAIT_V(8); PG8_WAIT_L(0); PG8_BAR; PG8_MMA(1, 0, At, B0); PG8_MMA(1, 1, At, B1); PG8_BAR; PG8_SCHED;
            PG8_LDB(B0, 1, 0); PG8_LDB(B1, 1, 1); PG8_SCHED; PG8_LDA(At, 1, 0); PG8_STAGE(PG8_SA(0, 1), a2 + hstep, voffA);
            PG8_WAIT_V(8); PG8_WAIT_L(0); PG8_BAR; PG8_MMA(0, 0, At, B0); PG8_MMA(0, 1, At, B1); PG8_BAR; PG8_SCHED;
            PG8_LDA(At, 1, 1); PG8_STAGE(PG8_SB(1, 0), b3, voffB); PG8_STAGE(PG8_SB(1, 1), b3 + hstep, voffB); PG8_STAGE(PG8_SA(1, 0), a3, voffA);
            PG8_WAIT_V(8); PG8_WAIT_L(0); PG8_BAR; PG8_MMA(1, 0, At, B0); PG8_MMA(1, 1, At, B1); PG8_BAR; PG8_SCHED;
            } else {
            PG8_LDB(B0, 0, 0); PG8_SCHED; PG8_LDA(At, 0, 0); PG8_STAGE(PG8_SA(1, 1), a1 + hstep, voffA);
            PG8_WAIT_L(8); PG8_BAR; PG8_WAIT_L(0); PG8_MMA(0, 0, At, B0); PG8_BAR; PG8_SCHED;
            PG8_LDB(B1, 0, 1); PG8_STAGE(PG8_SB(0, 0), b2, voffB);
            PG8_BAR; PG8_WAIT_L(0); PG8_MMA(0, 1, At, B1); PG8_BAR;
            PG8_LDA(At, 0, 1); PG8_STAGE(PG8_SA(0, 0), a2, voffA);
            PG8_BAR; PG8_WAIT_L(0); PG8_MMA(1, 0, At, B0); PG8_BAR; PG8_SCHED;
            PG8_STAGE(PG8_SB(0, 1), b2 + hstep, voffB);
            PG8_WAIT_V(6); PG8_BAR; PG8_MMA(1, 1, At, B1); PG8_BAR;
            PG8_LDB(B0, 1, 0); PG8_SCHED; PG8_LDA(At, 1, 0); PG8_STAGE(PG8_SA(0, 1), a2 + hstep, voffA);
            PG8_WAIT_L(8); PG8_BAR; PG8_WAIT_L(0); PG8_MMA(0, 0, At, B0); PG8_BAR; PG8_SCHED;
            PG8_LDB(B1, 1, 1); PG8_STAGE(PG8_SB(1, 0), b3, voffB);
            PG8_BAR; PG8_WAIT_L(0); PG8_MMA(0, 1, At, B1); PG8_BAR;
            PG8_LDA(At, 1, 1); PG8_STAGE(PG8_SA(1, 0), a3, voffA);
            PG8_BAR; PG8_WAIT_L(0); PG8_MMA(1, 0, At, B0); PG8_BAR; PG8_SCHED;
            PG8_STAGE(PG8_SB(1, 1), b3 + hstep, voffB);
            PG8_WAIT_V(6); PG8_BAR; PG8_MMA(1, 1, At, B1); PG8_BAR;
            }
        }
        if constexpr (ALIGN_EPI) { if (wr == 0) PG8_BAR; }
        if constexpr (!Epi::AFTER_DRAIN) { E(acc, cur, wr, wc, fr, fq, ui); S.done(cur); }
        if (!has_next) break;
#pragma unroll
        for (int a = 0; a < 2; ++a)
#pragma unroll
            for (int b = 0; b < 2; ++b)
#pragma unroll
                for (int m = 0; m < 4; ++m)
#pragma unroll
                    for (int n = 0; n < 2; ++n) acc[a][b][m][n] = (f32x4){0.f, 0.f, 0.f, 0.f};
        cur = nxt; cA = nA; cB = nB; ++ui;
        if constexpr (ALIGN_EPI) { if (wr == 1) PG8_BAR; }
    }
    PG8_WAIT_V(0);
    if constexpr (!ALIGN_EPI) { if (wr == 0) PG8_BAR; }
    PG8_BAR;
    if constexpr (Epi::AFTER_DRAIN) { E.fused(acc, cur, wr, wc, fr, fq, lds, wid, lane); S.done(cur); }
#undef PG8_SA
#undef PG8_SB
#undef PG8_STAGE
#undef PG8_LDA
#undef PG8_LDB
#undef PG8_MMA
#undef PG8_WAIT_V
#undef PG8_WAIT_L
#undef PG8_BAR
#undef PG8_SCHED
}
}

#ifndef PG8_SP2
#define PG8_SP2 true
#endif
#ifndef PG8_ALIGN
#define PG8_ALIGN true
#endif

#define LAS __attribute__((address_space(3)))
typedef unsigned short bf16_t;
typedef short bf16x8 __attribute__((ext_vector_type(8)));
typedef short s16x4 __attribute__((ext_vector_type(4)));
typedef float f32x4 __attribute__((ext_vector_type(4)));
typedef unsigned u32x4 __attribute__((ext_vector_type(4)));
typedef unsigned u32x2 __attribute__((ext_vector_type(2)));

constexpr int NWAVES = 8, NTHR = 512;
constexpr int DM = 1024, SEQ = 2048, NB = 32, DSEQ = 16, LW = 512, NH = 8, HD = 64, DFF = 2816, INC = 2560;
constexpr int MP = NB * SEQ, MS = NB * DSEQ, MT = MP + MS;
constexpr float EPS = 1e-6f, LOG2E = 1.4426950408889634f;
constexpr int LDS_BYTES = 147456;

constexpr size_t MiB = 1u << 20;
constexpr size_t WS_CTR = 3 * (1u << 20);
constexpr size_t WS_PCNT = 3 * (1u << 20) + 131072;
constexpr size_t WS_BAR = 3 * (1u << 20) + 65536;
constexpr size_t WS_SSQL = 0, WS_SSQA = 512 * 1024, WS_SSQ1 = 1024 * 1024, WS_SSQ2 = 1536 * 1024, WS_RS1 = 2 * MiB;
constexpr size_t WS_W1 = 4 * MiB, WS_W2 = 9 * MiB, WS_W3 = 11 * MiB, WS_W4 = 22 * MiB, WS_CK = 28 * MiB, WS_CV = 44 * MiB;
constexpr size_t WS_H = 64 * MiB;
constexpr size_t WS_XB = 420 * MiB;
constexpr size_t WS_Y = 552 * MiB;
constexpr size_t WS_SSQP = 684 * MiB;
constexpr size_t WS_PART = 690 * MiB;
constexpr size_t WS_SLOT = 714 * MiB;
constexpr size_t WS_END = 716 * MiB;

struct Params {
    const float* in[24];
    float* out;
    unsigned char* ws;
};

__device__ __forceinline__ float bf2f(unsigned short b) { return __uint_as_float((unsigned)b << 16); }
__device__ __forceinline__ unsigned pk2(float lo, float hi) { return pg8::cvt_pk_bf16(lo, hi); }
__device__ __forceinline__ float wave_sum(float v) {
#pragma unroll
    for (int o = 1; o < 64; o <<= 1) v += __shfl_xor(v, o);
    return v;
}
__device__ __forceinline__ float fast_sigmoid(float z) { return __builtin_amdgcn_rcpf(1.0f + __builtin_amdgcn_exp2f(-LOG2E * z)); }
__device__ __forceinline__ float gelu_tanh(float x) {
    const float z = 0.7978845608028654f * (x + 0.044715f * x * x * x);
    const float e = __builtin_amdgcn_exp2f(2.0f * LOG2E * z);
    const float th = 1.0f - 2.0f * __builtin_amdgcn_rcpf(e + 1.0f);
    return 0.5f * x * (1.0f + th);
}

__device__ __forceinline__ void p0_transpose_item(const float* W, int K, int N, const float* g0, const float* g1, bf16_t* WT, int dst_row0, int k0, int n0, float* scr, int lane) {
#pragma unroll 8
    for (int i = 0; i < 32; ++i) { const int kk = 2 * i + (lane >> 5); const int k = k0 + kk;
        float sc = 1.f; if (g0) sc = (g1 && k >= 512) ? g1[k - 512] : g0[k];
        scr[kk * 33 + (lane & 31)] = W[(size_t)k * N + n0 + (lane & 31)] * sc; }
    asm volatile("s_waitcnt lgkmcnt(0)" ::: "memory");
    const int c = lane & 7;
#pragma unroll
    for (int j = 0; j < 4; ++j) { const int n = (lane >> 3) + 8 * j; const float* s = scr + (8 * c) * 33 + n;
        u32x4 o; o.x = pk2(s[0 * 33], s[1 * 33]); o.y = pk2(s[2 * 33], s[3 * 33]); o.z = pk2(s[4 * 33], s[5 * 33]); o.w = pk2(s[6 * 33], s[7 * 33]);
        *(u32x4*)(WT + (size_t)(dst_row0 + n0 + n) * K + k0 + 8 * c) = o; }
    asm volatile("s_waitcnt lgkmcnt(0)" ::: "memory");
}

__device__ __forceinline__ void p0_weights(const Params& p, unsigned char* lds, int tid, int lo, int hi, int wg0, int nwg) {
    const int lane = tid & 63, wave = tid >> 6;
    float* scr = (float*)(lds + wave * 16384);
    unsigned char* ws = p.ws;
    bf16_t* W1 = (bf16_t*)(ws + WS_W1); bf16_t* W2 = (bf16_t*)(ws + WS_W2); bf16_t* W3 = (bf16_t*)(ws + WS_W3); bf16_t* W4 = (bf16_t*)(ws + WS_W4);
    constexpr int I1 = 16 * 80, I2 = 16 * 32, I3 = 16 * 88;
    if ((int)blockIdx.x < wg0 || (int)blockIdx.x >= wg0 + nwg) return;
    for (int it = lo + ((int)blockIdx.x - wg0) * NWAVES + wave; it < hi; it += nwg * NWAVES) {
        int r = it;
        if (r < I1) { const int kb = r / 80, nb = r % 80; p0_transpose_item(p.in[7], DM, INC, p.in[6], nullptr, W1, 0, kb * 64, nb * 32, scr, lane); continue; } r -= I1;
        if (r < I2) { const int kb = r / 32, nb = r % 32; p0_transpose_item(p.in[18], DM, DM, p.in[16], p.in[17], W2, 0, kb * 64, nb * 32, scr, lane); continue; } r -= I2;
        if (r < I3) { const int kb = r / 88, nb = r % 88; const int n0 = nb * 32; p0_transpose_item(p.in[20], DM, DFF, p.in[19], nullptr, W3, 256 * (n0 / 128) + (n0 % 128) - n0, kb * 64, n0, scr, lane); continue; } r -= I3;
        if (r < I3) { const int kb = r / 88, nb = r % 88; const int n0 = nb * 32; p0_transpose_item(p.in[21], DM, DFF, p.in[19], nullptr, W3, 256 * (n0 / 128) + 128 + (n0 % 128) - n0, kb * 64, n0, scr, lane); continue; } r -= I3;
        { const int kb = r / 32, nb = r % 32; p0_transpose_item(p.in[22], DFF, DM, nullptr, nullptr, W4, 0, kb * 64, nb * 32, scr, lane); }
    }
}
constexpr int WI_1 = 16 * 80, WI_2 = WI_1 + 16 * 32, WI_END = WI_2 + 2 * 16 * 88 + 44 * 32;
__device__ __forceinline__ void p0_cache(const Params& p, int tid, int wg0, int nwg) {
    if ((int)blockIdx.x < wg0 || (int)blockIdx.x >= wg0 + nwg) return;
    unsigned char* ws = p.ws;
    const int gt = ((int)blockIdx.x - wg0) * NTHR + tid, NGT = nwg * NTHR;
    bf16_t* CK = (bf16_t*)(ws + WS_CK); bf16_t* CV = (bf16_t*)(ws + WS_CV);
    constexpr int NC8 = NB * 512 * 512 / 8;
    for (int i0 = gt; i0 < 2 * NC8; i0 += 4 * NGT) {
        f32x4 a[4], b[4];
#pragma unroll
        for (int u = 0; u < 4; ++u) { const int i = i0 + u * NGT; if (i < 2 * NC8) { const int which = i >= NC8; const int e = (which ? i - NC8 : i);
            const f32x4* src = (const f32x4*)(which ? p.in[5] : p.in[4]) + (size_t)e * 2; a[u] = src[0]; b[u] = src[1]; } }
#pragma unroll
        for (int u = 0; u < 4; ++u) { const int i = i0 + u * NGT; if (i < 2 * NC8) { const int which = i >= NC8; const int e = (which ? i - NC8 : i);
            u32x4 w; w.x = pk2(a[u].x, a[u].y); w.y = pk2(a[u].z, a[u].w); w.z = pk2(b[u].x, b[u].y); w.w = pk2(b[u].z, b[u].w);
            *((u32x4*)(which ? CV : CK) + e) = w; } }
    }
}
__device__ __forceinline__ void p0_prologue(const Params& p, unsigned char* lds, int tid, int G) {
    const int lane = tid & 63, wave = tid >> 6;
    const int gw = blockIdx.x * NWAVES + wave, NGW = G * NWAVES;
    unsigned char* ws = p.ws;
    p0_weights(p, lds, tid, 0, WI_1, 0, G);
    bf16_t* XB = (bf16_t*)(ws + WS_XB); float* rs1 = (float*)(ws + WS_RS1);
    for (int m0 = 4 * gw; m0 < MT; m0 += 4 * NGW) {
        f32x4 v[4][4];
#pragma unroll
        for (int r = 0; r < 4; ++r) { const int m = m0 + r; const float* xrow = m < MP ? p.in[0] + (size_t)m * DM : p.in[1] + (size_t)(m - MP) * DM;
            const f32x4* xr = (const f32x4*)xrow + lane;
#pragma unroll
            for (int j = 0; j < 4; ++j) v[r][j] = xr[64 * j]; }
#pragma unroll
        for (int r = 0; r < 4; ++r) { const int m = m0 + r; float s = 0.f;
#pragma unroll
            for (int j = 0; j < 4; ++j) s += (v[r][j].x * v[r][j].x + v[r][j].y * v[r][j].y) + (v[r][j].z * v[r][j].z + v[r][j].w * v[r][j].w);
            s = wave_sum(s);
            const float rs = __builtin_amdgcn_rsqf(s * (1.f / DM) + EPS);
            u32x2* o8 = (u32x2*)(XB + (size_t)m * DM) + lane;
#pragma unroll
            for (int j = 0; j < 4; ++j) { u32x2 w; w.x = pk2(v[r][j].x * rs, v[r][j].y * rs); w.y = pk2(v[r][j].z * rs, v[r][j].w * rs); o8[64 * j] = w; } }
    }
    const int gt = blockIdx.x * NTHR + tid, NGT = G * NTHR;
    float* z0 = (float*)(ws + WS_SSQL); float* z1 = (float*)(ws + WS_SSQA); float* z2 = (float*)(ws + WS_SSQ1); float* z3 = (float*)(ws + WS_SSQ2);
    for (int i = gt; i < MT; i += NGT) { z2[i] = 0.f; z3[i] = 0.f; }
    if (gt < 8) *((unsigned*)(ws + WS_CTR) + 64 * gt) = 0u;
    for (int i = gt; i < 3456; i += NGT) ((unsigned*)(ws + WS_BAR))[i] = 0u;
    for (int i = gt; i < 256 * 64; i += NGT) ((unsigned*)(ws + WS_PCNT))[i] = 0u;
}

#define LDS_BAR() asm volatile("s_waitcnt lgkmcnt(0)\n\ts_barrier" ::: "memory")
constexpr int L_WA = 0, L_WX = 9216, L_U = 18432, L_UC = 35584, L_UCB = 53248, L_A = 62464, L_BT = 79872, L_SEGA = 97280, L_SEGB = 99328, L_CW = 101376, L_GL = 102656, L_END = 110848;
constexpr int FS = 68;
__device__ __forceinline__ void lru_item(const Params& p, unsigned char* lds, int tid, int b, int n, bool samp, float* ssqL) {
    asm volatile("" : "+v"(tid));
    const int lane = tid & 63, w = tid >> 6, fr = lane & 15, g = lane >> 4;
    unsigned char* ws = p.ws;
    const bf16_t* PROJ = (const bf16_t*)(ws + WS_H); bf16_t* Y = (bf16_t*)(ws + WS_Y);
    const int T = samp ? DSEQ : SEQ;
    const size_t row0 = samp ? (size_t)MP + (size_t)b * DSEQ : (size_t)b * SEQ;
    bf16_t* WA = (bf16_t*)(lds + L_WA); bf16_t* WX = (bf16_t*)(lds + L_WX);
    float* U = (float*)(lds + L_U); float* UC = (float*)(lds + L_UC); bf16_t* UCB = (bf16_t*)(lds + L_UCB);
    float* A = (float*)(lds + L_A); float* BT = (float*)(lds + L_BT); float* SEGA = (float*)(lds + L_SEGA); float* SEGB = (float*)(lds + L_SEGB); float* CW = (float*)(lds + L_CW);
    bf16_t* GL = (bf16_t*)(lds + L_GL);
    const int tr = tid >> 3, c8 = (tid & 7) * 8;
    u32x4 upre = {0u, 0u, 0u, 0u}, gpre = {0u, 0u, 0u, 0u};
    if (tr < T) { const bf16_t* src = PROJ + (row0 + tr) * INC + n * 64 + c8; upre = *(const u32x4*)src; gpre = *(const u32x4*)(src + LW); }
    __syncthreads();
    {
        const int c = tid >> 3, d8 = (tid & 7) * 8;
        const float* wa = p.in[10] + ((size_t)n * 64 + c) * 64 + d8; const float* wx = p.in[12] + ((size_t)n * 64 + c) * 64 + d8;
        const f32x4 a0 = *(const f32x4*)wa, a1 = *(const f32x4*)(wa + 4), x0 = *(const f32x4*)wx, x1 = *(const f32x4*)(wx + 4);
        const float av[8] = {a0.x, a0.y, a0.z, a0.w, a1.x, a1.y, a1.z, a1.w}; const float xv[8] = {x0.x, x0.y, x0.z, x0.w, x1.x, x1.y, x1.z, x1.w};
#pragma unroll
        for (int j = 0; j < 8; ++j) { WA[(d8 + j) * 72 + c] = (bf16_t)(pk2(av[j], 0.f) & 0xffffu); WX[(d8 + j) * 72 + c] = (bf16_t)(pk2(xv[j], 0.f) & 0xffffu); }
        if (tid < 256) CW[tid] = p.in[8][(size_t)(tid >> 6) * LW + n * 64 + (tid & 63)];
        else if (tid < 320) CW[tid] = p.in[9][n * 64 + (tid & 63)];
        if (tid < 192) U[tid] = samp ? p.in[2][((size_t)b * 3 + (tid >> 6)) * LW + n * 64 + (tid & 63)] : 0.f;
    }
    const int mt = w & 3, nh = w >> 2;
    float cba[2], cbx[2], cL[2];
#pragma unroll
    for (int ni = 0; ni < 2; ++ni) { const int d = n * 64 + 32 * nh + 16 * ni + fr; cba[ni] = p.in[11][d]; cbx[ni] = p.in[13][d];
        const float lam = p.in[14][d]; cL[ni] = -8.0f * log1pf(expf(-lam)) * LOG2E; }
    float Hreg = samp ? p.in[3][(size_t)b * LW + n * 64 + lane] : 0.f;
    float hlast = 0.f;
    for (int t0 = 0; t0 < T; t0 += 64) {
        const int tv = (T - t0) < 64 ? (T - t0) : 64;
        { float* dst = U + (3 + tr) * 64 + c8;
          *(f32x4*)dst = (f32x4){__uint_as_float(upre.x << 16), __uint_as_float(upre.x & 0xffff0000u), __uint_as_float(upre.y << 16), __uint_as_float(upre.y & 0xffff0000u)};
          *(f32x4*)(dst + 4) = (f32x4){__uint_as_float(upre.z << 16), __uint_as_float(upre.z & 0xffff0000u), __uint_as_float(upre.w << 16), __uint_as_float(upre.w & 0xffff0000u)};
          *(u32x4*)(GL + tr * 64 + c8) = gpre;
          if (t0 + 64 + tr < T) { const bf16_t* src = PROJ + (row0 + t0 + 64 + tr) * INC + n * 64 + c8; upre = *(const u32x4*)src; gpre = *(const u32x4*)(src + LW); } }
        LDS_BAR();
        { const int t = tr;
          f32x4 o0 = *(const f32x4*)(CW + 256 + c8), o1 = *(const f32x4*)(CW + 256 + c8 + 4);
#pragma unroll
          for (int k = 0; k < 4; ++k) { const f32x4 w0 = *(const f32x4*)(CW + k * 64 + c8), w1 = *(const f32x4*)(CW + k * 64 + c8 + 4);
              const f32x4 u0 = *(const f32x4*)(U + (t + k) * 64 + c8), u1 = *(const f32x4*)(U + (t + k) * 64 + c8 + 4); o0 += w0 * u0; o1 += w1 * u1; }
          *(f32x4*)(UC + t * FS + c8) = o0; *(f32x4*)(UC + t * FS + c8 + 4) = o1;
          u32x4 wv; wv.x = pk2(o0.x, o0.y); wv.y = pk2(o0.z, o0.w); wv.z = pk2(o1.x, o1.y); wv.w = pk2(o1.z, o1.w);
          *(u32x4*)(UCB + t * 72 + c8) = wv; }
        LDS_BAR();
        { bf16x8 af[2];
#pragma unroll
          for (int ks = 0; ks < 2; ++ks) af[ks] = *(const bf16x8*)(UCB + (16 * mt + fr) * 72 + 32 * ks + 8 * g);
#pragma unroll
          for (int ni = 0; ni < 2; ++ni) { const int dl = 32 * nh + 16 * ni + fr;
              f32x4 ca = {0.f, 0.f, 0.f, 0.f}, cx = {0.f, 0.f, 0.f, 0.f};
#pragma unroll
              for (int ks = 0; ks < 2; ++ks) { const bf16x8 ba = *(const bf16x8*)(WA + dl * 72 + 32 * ks + 8 * g), bx = *(const bf16x8*)(WX + dl * 72 + 32 * ks + 8 * g);
                  ca = __builtin_amdgcn_mfma_f32_16x16x32_bf16(af[ks], ba, ca, 0, 0, 0); cx = __builtin_amdgcn_mfma_f32_16x16x32_bf16(af[ks], bx, cx, 0, 0, 0); }
#pragma unroll
              for (int r = 0; r < 4; ++r) { const int t = 16 * mt + 4 * g + r;
                  const float rr = fast_sigmoid(ca[r] + cba[ni]), ii = fast_sigmoid(cx[r] + cbx[ni]);
                  const float a = __builtin_amdgcn_exp2f(rr * cL[ni]);
                  const float gain = __builtin_amdgcn_sqrtf(fmaxf(1.0f - a * a, 0.f));
                  A[t * FS + dl] = a; BT[t * FS + dl] = gain * ii * UC[t * FS + dl]; } } }
        float ucarry = 0.f; if (tid < 192) ucarry = U[(64 + (tid >> 6)) * 64 + (tid & 63)];
        LDS_BAR();
        if (tid < 192) U[tid] = ucarry;
        float hloc[8], cum[8];
        { float hl = 0.f, ca = 1.f;
#pragma unroll
          for (int s = 0; s < 8; ++s) { const int t = 8 * w + s; const float a = A[t * FS + lane], bb = BT[t * FS + lane]; hl = a * hl + bb; ca *= a; hloc[s] = hl; cum[s] = ca; }
          SEGA[w * 64 + lane] = ca; SEGB[w * 64 + lane] = hl; }
        LDS_BAR();
        { float hcur = Hreg, hin = 0.f; const int lastseg = (tv >> 3) - 1;
#pragma unroll
          for (int s = 0; s < 8; ++s) { if (s == w) hin = hcur; hcur = SEGA[s * 64 + lane] * hcur + SEGB[s * 64 + lane]; if (s == lastseg) hlast = hcur; }
          Hreg = hcur;
#pragma unroll
          for (int s = 0; s < 8; ++s) UC[(8 * w + s) * FS + lane] = hloc[s] + cum[s] * hin; }
        LDS_BAR();
        { const f32x4 h0 = *(const f32x4*)(UC + tr * FS + c8), h1 = *(const f32x4*)(UC + tr * FS + c8 + 4);
          const u32x4 gr = *(const u32x4*)(GL + tr * 64 + c8);
          const float y0 = gelu_tanh(__uint_as_float(gr.x << 16)) * h0.x, y1 = gelu_tanh(__uint_as_float(gr.x & 0xffff0000u)) * h0.y;
          const float y2 = gelu_tanh(__uint_as_float(gr.y << 16)) * h0.z, y3 = gelu_tanh(__uint_as_float(gr.y & 0xffff0000u)) * h0.w;
          const float y4 = gelu_tanh(__uint_as_float(gr.z << 16)) * h1.x, y5 = gelu_tanh(__uint_as_float(gr.z & 0xffff0000u)) * h1.y;
          const float y6 = gelu_tanh(__uint_as_float(gr.w << 16)) * h1.z, y7 = gelu_tanh(__uint_as_float(gr.w & 0xffff0000u)) * h1.w;
          float ss = (y0 * y0 + y1 * y1) + (y2 * y2 + y3 * y3) + (y4 * y4 + y5 * y5) + (y6 * y6 + y7 * y7);
          ss += __shfl_xor(ss, 1); ss += __shfl_xor(ss, 2); ss += __shfl_xor(ss, 4);
          if (tr < tv) { u32x4 wv; wv.x = pk2(y0, y1); wv.y = pk2(y2, y3); wv.z = pk2(y4, y5); wv.w = pk2(y6, y7);
              *(u32x4*)(Y + (row0 + t0 + tr) * DM + n * 64 + c8) = wv;
              if ((tid & 7) == 0) ssqL[(row0 + t0 + tr) * 16 + n] = ss; } }
    }
    if (w == 0) p.out[(samp ? pg8::EO_SLRU : pg8::EO_PLRU) + (size_t)b * LW + n * 64 + lane] = hlast;
}

constexpr int VSTR = 128;
constexpr int A_VT = 0, A_Q = 8 * 64 * VSTR, A_TBL = 2 * A_Q, A_END = A_TBL + 8 * 1280;
struct KVSrc { const bf16_t* k; const bf16_t* v; int stride; int nvalid; };
typedef short v4i16_t __attribute__((ext_vector_type(4)));
__device__ __forceinline__ s16x4 vtr(LAS const unsigned char* pp) { return __builtin_bit_cast(s16x4, __builtin_amdgcn_ds_read_tr16_b64_v4i16((LAS v4i16_t*)(pp))); }

template <int NJ, class Src>
__device__ __forceinline__ void attn_item(LAS unsigned char* vlds, LAS const float* tbl, const bf16_t* Q, int qstride, const Src& src, int jt0, int jt1, bf16_t* O, float* ssq, int lane) {
    const int fr = lane & 15, g = lane >> 4;
    bf16x8 qf[NJ][2];
#pragma unroll
    for (int nj = 0; nj < NJ; ++nj)
#pragma unroll
        for (int ks = 0; ks < 2; ++ks) qf[nj][ks] = *(const bf16x8*)((const char*)(Q + (size_t)(16 * nj) * qstride + 32 * ks) + (unsigned)((fr * qstride + 8 * g) * 2));
    f32x4 Oa[4][NJ]; float mrun[NJ], lsum[NJ];
#pragma unroll
    for (int nj = 0; nj < NJ; ++nj) { mrun[nj] = -INFINITY; lsum[nj] = 0.f;
#pragma unroll
        for (int md = 0; md < 4; ++md) Oa[md][nj] = (f32x4){0.f, 0.f, 0.f, 0.f}; }
    const float c1 = 0.125f * LOG2E;
    int voff[4];
    { const int q = fr >> 2, pp = fr & 3, x = (4 * g + q) & 7;
#pragma unroll
      for (int md = 0; md < 4; ++md) voff[md] = (4 * g + q) * VSTR + (((2 * md + (pp >> 1)) ^ x) * 16) + 8 * (pp & 1); }
    const int dkey = lane >> 3, dch = ((lane & 7) ^ (lane >> 3)) * 8;
    bf16x8 kn[2][2];
    { const KVSrc s = src(jt0); const unsigned klo = (unsigned)((fr * s.stride + 8 * g) * 2), vlo = (unsigned)((dkey * s.stride + dch) * 2);
#pragma unroll
      for (int mi = 0; mi < 2; ++mi) { const char* kb = (const char*)(s.k + (size_t)(16 * mi < s.nvalid ? 16 * mi : 0) * s.stride); kn[mi][0] = *(const bf16x8*)(kb + klo); kn[mi][1] = *(const bf16x8*)(kb + 64 + klo); }
      asm volatile("s_waitcnt lgkmcnt(0)" ::: "memory");
#pragma unroll
      for (int i = 0; i < 4; ++i) { const char* vb = (const char*)(s.v + (size_t)(8 * i < s.nvalid ? 8 * i : 0) * s.stride);
          __builtin_amdgcn_global_load_lds((const unsigned*)(vb + vlo), (LAS unsigned*)(vlds + i * 1024), 16, 0, 0); } }
    for (int jt = jt0; jt < jt1; ++jt) {
        const int buf = (jt - jt0) & 1; const bool more = jt + 1 < jt1;
        const KVSrc s = src(jt);
        bf16x8 kc[2][2];
#pragma unroll
        for (int mi = 0; mi < 2; ++mi) { kc[mi][0] = kn[mi][0]; kc[mi][1] = kn[mi][1]; }
        if (more) {
            const KVSrc sn = src(jt + 1); const unsigned klo = (unsigned)((fr * sn.stride + 8 * g) * 2), vlo = (unsigned)((dkey * sn.stride + dch) * 2);
#pragma unroll
            for (int mi = 0; mi < 2; ++mi) { const char* kb = (const char*)(sn.k + (size_t)(16 * mi < sn.nvalid ? 16 * mi : 0) * sn.stride); kn[mi][0] = *(const bf16x8*)(kb + klo); kn[mi][1] = *(const bf16x8*)(kb + 64 + klo); }
            asm volatile("s_waitcnt lgkmcnt(0)" ::: "memory");
#pragma unroll
            for (int i = 0; i < 4; ++i) { const char* vb = (const char*)(sn.v + (size_t)(8 * i < sn.nvalid ? 8 * i : 0) * sn.stride);
                __builtin_amdgcn_global_load_lds((const unsigned*)(vb + vlo), (LAS unsigned*)(vlds + (buf ^ 1) * 4096 + i * 1024), 16, 0, 0); }
        }
        f32x4 S[2][NJ];
#pragma unroll
        for (int mi = 0; mi < 2; ++mi)
#pragma unroll
            for (int nj = 0; nj < NJ; ++nj) { f32x4 a = {0.f, 0.f, 0.f, 0.f};
                a = __builtin_amdgcn_mfma_f32_16x16x32_bf16(kc[mi][0], qf[nj][0], a, 0, 0, 0); a = __builtin_amdgcn_mfma_f32_16x16x32_bf16(kc[mi][1], qf[nj][1], a, 0, 0, 0); S[mi][nj] = a; }
        if (jt <= 11) { const float bc = tbl[256];
#pragma unroll
            for (int mi = 0; mi < 2; ++mi)
#pragma unroll
                for (int nj = 0; nj < NJ; ++nj) S[mi][nj] = S[mi][nj] * c1 + bc;
        } else { LAS const float* tb = tbl + (640 - 32 * jt - 64 + fr - 4 * g);
#pragma unroll
            for (int mi = 0; mi < 2; ++mi)
#pragma unroll
                for (int nj = 0; nj < NJ; ++nj)
#pragma unroll
                    for (int r = 0; r < 4; ++r) S[mi][nj][r] = S[mi][nj][r] * c1 + tb[64 + 16 * nj - 16 * mi - r];
        }
        if (s.nvalid < 32) {
#pragma unroll
            for (int mi = 0; mi < 2; ++mi)
#pragma unroll
                for (int nj = 0; nj < NJ; ++nj)
#pragma unroll
                    for (int r = 0; r < 4; ++r) if (16 * mi + 4 * g + r >= s.nvalid) S[mi][nj][r] = -INFINITY;
        }
        float mx[NJ]; bool grow = false;
#pragma unroll
        for (int nj = 0; nj < NJ; ++nj) {
            float m = fmaxf(fmaxf(fmaxf(S[0][nj][0], S[0][nj][1]), fmaxf(S[0][nj][2], S[0][nj][3])), fmaxf(fmaxf(S[1][nj][0], S[1][nj][1]), fmaxf(S[1][nj][2], S[1][nj][3])));
            m = rows_max(m); mx[nj] = m;
            grow = grow || (m > mrun[nj] + 8.0f);
        }
        if (__builtin_amdgcn_ballot_w64(grow) != 0ull) {
#pragma unroll
            for (int nj = 0; nj < NJ; ++nj) { const float mnew = fmaxf(mrun[nj], mx[nj]); const float alpha = __builtin_amdgcn_exp2f(mrun[nj] - mnew); mrun[nj] = mnew; lsum[nj] *= alpha;
#pragma unroll
                for (int md = 0; md < 4; ++md) Oa[md][nj] = Oa[md][nj] * alpha; }
        }
        bf16x8 pf[NJ];
#pragma unroll
        for (int nj = 0; nj < NJ; ++nj) {
            float ps = 0.f;
#pragma unroll
            for (int mi = 0; mi < 2; ++mi)
#pragma unroll
                for (int r = 0; r < 4; ++r) { const float pv = __builtin_amdgcn_exp2f(S[mi][nj][r] - mrun[nj]); S[mi][nj][r] = pv; ps += pv; }
            lsum[nj] += ps;
            u32x4 w; w.x = pk2(S[0][nj][0], S[0][nj][1]); w.y = pk2(S[0][nj][2], S[0][nj][3]); w.z = pk2(S[1][nj][0], S[1][nj][1]); w.w = pk2(S[1][nj][2], S[1][nj][3]);
            pf[nj] = __builtin_bit_cast(bf16x8, w);
        }
        if (more) asm volatile("s_waitcnt vmcnt(8)" ::: "memory"); else asm volatile("s_waitcnt vmcnt(0)" ::: "memory");
        LAS const unsigned char* vb = vlds + buf * 4096;
#pragma unroll
        for (int md = 0; md < 4; ++md) {
            const s16x4 lo = vtr(vb + voff[md]), hi = vtr(vb + voff[md] + 16 * VSTR);
            const bf16x8 vf = {lo[0], lo[1], lo[2], lo[3], hi[0], hi[1], hi[2], hi[3]};
#pragma unroll
            for (int nj = 0; nj < NJ; ++nj) Oa[md][nj] = __builtin_amdgcn_mfma_f32_16x16x32_bf16(vf, pf[nj], Oa[md][nj], 0, 0, 0);
        }
    }
#pragma unroll
    for (int nj = 0; nj < NJ; ++nj) {
        float l = rows_sum(lsum[nj]);
        const float inv = __builtin_amdgcn_rcpf(l); float ss = 0.f;
        char* orow = (char*)(O + (size_t)(16 * nj) * DM) + (unsigned)((fr * DM + 4 * g) * 2);
#pragma unroll
        for (int md = 0; md < 4; ++md) { const f32x4 o = Oa[md][nj] * inv; ss += (o[0] * o[0] + o[1] * o[1]) + (o[2] * o[2] + o[3] * o[3]);
            u32x2 w; w.x = pk2(o[0], o[1]); w.y = pk2(o[2], o[3]); *(u32x2*)(orow + 32 * md) = w; }
        ss = rows_sum(ss);
        if (g == 0) ssq[(16 * nj + fr) * 16] = ss;
    }
}

struct SrcPrompt { const bf16_t* kbase; int c;
    __device__ __forceinline__ KVSrc operator()(int jt) const { const bf16_t* k = kbase + ((ptrdiff_t)(c - 8) * 64 + jt * 32) * INC; return KVSrc{k, k + 512, INC, 32}; } };
struct SrcSample { const bf16_t* ck; const bf16_t* cv; const bf16_t* knew;
    __device__ __forceinline__ KVSrc operator()(int jt) const { if (jt < 16) return KVSrc{ck + (size_t)(jt * 32) * 512, cv + (size_t)(jt * 32) * 512, 512, 32}; return KVSrc{knew, knew + 512, INC, 16}; } };

__device__ __forceinline__ void attn_tables(const Params& p, unsigned char* lds, int tid) {
    const int lane = tid & 63, h = __builtin_amdgcn_readfirstlane(tid >> 6);
    LAS float* tbl = (LAS float*)((LAS unsigned char*)lds + A_TBL + h * 1280);
    for (int i = lane; i < 320; i += 64) tbl[i] = p.in[15][h * 257 + (i < 256 ? i : 256)] * LOG2E;
}
__device__ __forceinline__ void attn_wg_item(const Params& p, unsigned char* lds, int tid, int it, float* ssqA) {
    asm volatile("" : "+v"(tid));
    const int lane = tid & 63, h = __builtin_amdgcn_readfirstlane(tid >> 6);
    unsigned char* ws = p.ws;
    const bf16_t* PROJ = (const bf16_t*)(ws + WS_H); bf16_t* Y = (bf16_t*)(ws + WS_Y);
    const bf16_t* CK = (const bf16_t*)(ws + WS_CK); const bf16_t* CV = (const bf16_t*)(ws + WS_CV);
    LAS unsigned char* vlds = (LAS unsigned char*)lds + A_VT + h * 64 * VSTR; LAS float* tbl = (LAS float*)((LAS unsigned char*)lds + A_TBL + h * 1280);
    if (it < NB * 32) {
        const int c = 31 - (it >> 5), b = it & 31;
        const size_t r0 = (size_t)b * SEQ + (size_t)c * 64;
        SrcPrompt src{PROJ + (size_t)b * SEQ * INC + 1536 + 64 * h, c};
        attn_item<4, SrcPrompt>(vlds, tbl, PROJ + r0 * INC + 1024 + 64 * h, INC, src, c >= 8 ? 0 : 2 * (8 - c), 18, Y + r0 * DM + 512 + 64 * h, ssqA + r0 * 16 + 8 + h, lane);
    } else {
        const int b = it - NB * 32; const size_t r0 = (size_t)MP + (size_t)b * DSEQ;
        SrcSample src{CK + (size_t)b * 512 * 512 + 64 * h, CV + (size_t)b * 512 * 512 + 64 * h, PROJ + r0 * INC + 1536 + 64 * h};
        attn_item<1, SrcSample>(vlds, tbl, PROJ + r0 * INC + 1024 + 64 * h, INC, src, 0, 17, Y + r0 * DM + 512 + 64 * h, ssqA + r0 * 16 + 8 + h, lane);
    }
}

__device__ __forceinline__ void final_norm(const Params& p, int tid, int G) {
    const int lane = tid & 63, wave = tid >> 6; const int gw = blockIdx.x * NWAVES + wave, NGW = G * NWAVES;
    const float* ssq2 = (const float*)(p.ws + WS_SSQ2); const f32x4* gn = (const f32x4*)p.in[23] + lane;
    f32x4 gv[4];
#pragma unroll
    for (int j = 0; j < 4; ++j) gv[j] = gn[64 * j];
    const float* part = (const float*)(p.ws + WS_PART);
    for (int m = NGW - 1 - gw; m < MS; m += NGW) {
        f32x4* xr = (f32x4*)(p.out + (size_t)(MP + m) * DM) + lane; f32x4 v[4];
#pragma unroll
        for (int j = 0; j < 4; ++j) v[j] = xr[64 * j];
        for (int ks = 0; ks < 11; ++ks) { const f32x4* pr = (const f32x4*)(part + ((size_t)ks * MS + m) * DM) + lane;
#pragma unroll
            for (int j = 0; j < 4; ++j) v[j] += pr[64 * j]; }
        float s = 0.f;
#pragma unroll
        for (int j = 0; j < 4; ++j) s += (v[j].x * v[j].x + v[j].y * v[j].y) + (v[j].z * v[j].z + v[j].w * v[j].w);
        s = wave_sum(s); const float sc = __builtin_amdgcn_rsqf(s * (1.f / DM) + EPS);
#pragma unroll
        for (int j = 0; j < 4; ++j) xr[64 * j] = v[j] * sc * gv[j];
    }
}

#define RLX_AGENT __ATOMIC_RELAXED, __HIP_MEMORY_SCOPE_AGENT
#define XB_TMO      128
#define XB_XCNT(j)  (256  + 64 * (j))
#define XB_XSUB(j)  (1280 + 64 * (j))
#define XB_XGEN(j)  (2304 + 64 * (j))
#define XB_TOP      3328
#define XB_TOPGEN   3392
#define XCD_BAR_WORDS 3456
#define XB_SPIN_CAP (1u << 18)

__device__ __forceinline__ unsigned xb_ld(unsigned* p)              { return __hip_atomic_load(p, __ATOMIC_RELAXED, __HIP_MEMORY_SCOPE_AGENT); }
__device__ __forceinline__ unsigned xb_add(unsigned* p, unsigned v) { return __hip_atomic_fetch_add(p, v, __ATOMIC_RELAXED, __HIP_MEMORY_SCOPE_AGENT); }
__device__ __forceinline__ unsigned xb_xcc_id() { return (unsigned)__builtin_amdgcn_s_getreg((3 << 11) | 20) & 0xFu; }
#define XB_SPIN(cond, bar) do { unsigned _sp = 0; while (cond) { __builtin_amdgcn_s_sleep(1); \
    if ((++_sp & 255u) == 0u) { if (xb_ld(&(bar)[XB_TMO])) break; if (_sp > XB_SPIN_CAP) { atomicAdd(&(bar)[XB_TMO], 1u); break; } } } } while (0)

struct XcdBarrier {
    unsigned* bar; unsigned x;
    volatile LAS unsigned* st;
};

__device__ __forceinline__ XcdBarrier xcd_barrier_post(unsigned* bar, volatile LAS unsigned* st) {
    XcdBarrier b; b.bar = bar; b.x = xb_xcc_id(); b.st = st;
    if (threadIdx.x == 0) (void)xb_add(&bar[XB_XCNT(b.x)], 1u);
    return b;
}
__device__ __forceinline__ void xcd_barrier_complete(unsigned* bar, unsigned x, unsigned& nloc, unsigned& nx) {
    const unsigned G = gridDim.x * gridDim.y * gridDim.z;
    unsigned sum, cnt, mine, sp = 0u;
    for (;;) {
        sum = 0u; cnt = 0u; mine = 0u;
#pragma unroll
        for (unsigned j = 0; j < 16; ++j) { const unsigned c = xb_ld(&bar[XB_XCNT(j)]); sum += c; cnt += (c > 0u) ? 1u : 0u; mine = (j == x) ? c : mine; }
        if (sum == G) break;
        __builtin_amdgcn_s_sleep(1);
        if ((++sp & 255u) == 0u) { if (xb_ld(&bar[XB_TMO])) break; if (sp > XB_SPIN_CAP) { atomicAdd(&bar[XB_TMO], 1u); break; } }
    }
    nloc = mine > 0u ? mine : 1u; nx = cnt > 0u ? cnt : 1u;
}

__device__ __forceinline__ void xcd_barrier(const XcdBarrier& b) {
    asm volatile("s_waitcnt vmcnt(0)" ::: "memory");
    __syncthreads();
    if (threadIdx.x == 0) {
        unsigned* bar = b.bar;
        __builtin_amdgcn_s_waitcnt(0);
        unsigned nloc = b.st[0], nx = b.st[1];
        if (nloc == 0u) { xcd_barrier_complete(bar, b.x, nloc, nx); b.st[0] = nloc; b.st[1] = nx; }
        const unsigned old = xb_add(&bar[XB_XSUB(b.x)], 1u);
        const unsigned gen = old / nloc;
        if (old + 1u == (gen + 1u) * nloc) {
            __builtin_amdgcn_fence(__ATOMIC_RELEASE, "agent");
            asm volatile("s_waitcnt vmcnt(0)" ::: "memory");
            const unsigned og = xb_add(&bar[XB_TOP], 1u);
            const unsigned tg = og / nx;
            if (og + 1u == (tg + 1u) * nx) xb_add(&bar[XB_TOPGEN], 1u);
            else XB_SPIN(xb_ld(&bar[XB_TOPGEN]) == tg, bar);
            __builtin_amdgcn_fence(__ATOMIC_ACQUIRE, "agent");
            xb_add(&bar[XB_XGEN(b.x)], 1u);
            asm volatile("s_waitcnt vmcnt(0)" ::: "memory");
        } else {
            XB_SPIN(xb_ld(&bar[XB_XGEN(b.x)]) == gen, bar);
            __builtin_amdgcn_fence(__ATOMIC_ACQUIRE, "agent");
            asm volatile("s_waitcnt vmcnt(0)" ::: "memory");
        }
    }
    __syncthreads();
}

#ifndef DIS_G1
#define DIS_G1 0
#endif
#ifndef DIS_G2
#define DIS_G2 0
#endif
#ifndef DIS_G3
#define DIS_G3 0
#endif
#ifndef DIS_G4
#define DIS_G4 0
#endif
__global__ void __launch_bounds__(NTHR, 2) mega_fwd(Params p, int ph_lo, int ph_hi) {
    extern __shared__ __attribute__((aligned(16))) unsigned char lds[];
    cg::grid_group grid = cg::this_grid();
    const int tid = threadIdx.x, G = gridDim.x;
    unsigned char* ws = p.ws;
#define IN(k) (ph_lo <= (k) && (k) < ph_hi)
    volatile LAS unsigned* bst = (volatile LAS unsigned*)((LAS unsigned char*)lds + LDS_BYTES - 32);
    if (tid < 2) bst[tid] = 0u;
    __syncthreads();
    XcdBarrier xbar; xbar.bar = (unsigned*)(ws + WS_BAR); xbar.x = 0; xbar.st = bst;
#define SEAM(k) do { if (IN(k) && IN((k) + 1)) { if ((k) == 0) { grid.sync(); xbar = xcd_barrier_post((unsigned*)(ws + WS_BAR), bst); } else xcd_barrier(xbar); } } while (0)
    if (IN(0)) { p0_prologue(p, lds, tid, G); }
    SEAM(0);
#ifndef DIS_GEMM
    if (IN(1) && !DIS_G1) {
        pg8::Gemm g{(const bf16_t*)(ws + WS_XB), (const bf16_t*)(ws + WS_W1), MT, INC, DM}; pg8::StaticOrder S; S.init(MT, INC, G, (int)blockIdx.x);
        pg8::Epi1 E{(bf16_t*)(ws + WS_H), (const float*)(ws + WS_RS1), p.out};
        pg8::gemm_phase<pg8::Epi1, pg8::StaticOrder, PG8_ALIGN, PG8_SP2>((LAS unsigned char*)lds, g, S, E);
        if (G == 256) { p0_weights(p, lds, tid, WI_1, WI_2, 20, 236); p0_cache(p, tid, 20, 236); } else { p0_weights(p, lds, tid, WI_1, WI_2, 0, G); p0_cache(p, tid, 0, G); }
    }
#endif
    SEAM(1);
    if (IN(2)) {
        attn_tables(p, lds, tid);
        LAS unsigned* qslot = (LAS unsigned*)((LAS unsigned char*)lds + LDS_BYTES - 16);
        unsigned* ctr = (unsigned*)(ws + WS_CTR);
        const unsigned xcc = xb_xcc_id() & 7u;
        for (unsigned qo = 0; qo < 8; ++qo) {
            const int q = (int)((xcc + qo) & 7u);
            for (;;) {
                __syncthreads();
                if (tid == 0) *qslot = atomicAdd(ctr + 64 * q, 1u);
                __syncthreads();
                const int it = __builtin_amdgcn_readfirstlane((int)*qslot);
                if (it >= 196) break;
                int aj = -1;
                if (it < 64) { if (it & 1) aj = it >> 1; else { const int j = it >> 1; lru_item(p, lds, tid, q + 8 * (j >> 3), j & 7, false, (float*)(ws + WS_SSQP)); } }
                else if (it < 96) { const int j = it - 64; lru_item(p, lds, tid, q + 8 * (j >> 3), j & 7, true, (float*)(ws + WS_SSQP)); }
                else if (it < 100) attn_wg_item(p, lds, tid, NB * 32 + q + 8 * (it - 96), (float*)(ws + WS_SSQP));
                else aj = 32 + (it - 100);
                if (aj >= 0) attn_wg_item(p, lds, tid, ((aj & 31) << 5) | (q + 8 * (aj >> 5)), (float*)(ws + WS_SSQP));
            }
        }
    }
    SEAM(2);
#ifndef DIS_GEMM
    if (IN(3) && !DIS_G2) {
        pg8::Gemm g{(const bf16_t*)(ws + WS_Y), (const bf16_t*)(ws + WS_W2), MT, DM, DM}; pg8::StaticOrder S; S.init(MT, DM, G, (int)blockIdx.x);
        LAS float* tab = (LAS float*)((LAS unsigned char*)lds + 131072);
        { const f32x4* sp = (const f32x4*)(ws + WS_SSQP); pg8::Unit u;
          for (int i = 0; i < 6; ++i) { if (!S.next(i, u)) break; if (tid < 256) { const int row = u.pm * 256 + tid; const f32x4 l0 = sp[row * 4], l1 = sp[row * 4 + 1], a0 = sp[row * 4 + 2], a1 = sp[row * 4 + 3];
              const float l = (((l0.x + l0.y) + (l0.z + l0.w)) + ((l1.x + l1.y) + (l1.z + l1.w))) * (1.f / 512.f) + EPS, a = (((a0.x + a0.y) + (a0.z + a0.w)) + ((a1.x + a1.y) + (a1.z + a1.w))) * (1.f / 512.f) + EPS;
              tab[(i * 256 + tid) * 2] = sqrtf(a / l); tab[(i * 256 + tid) * 2 + 1] = __builtin_amdgcn_rsqf(a); } }
          __syncthreads(); }
        pg8::Epi2 E{p.in[0], p.in[1], p.out, (bf16_t*)(ws + WS_XB), tab, (float*)(ws + WS_SSQ1)};
        pg8::gemm_phase<pg8::Epi2, pg8::StaticOrder, PG8_ALIGN, PG8_SP2>((LAS unsigned char*)lds, g, S, E);
        if (G == 256) p0_weights(p, lds, tid, WI_2, WI_END, 8, 248); else p0_weights(p, lds, tid, WI_2, WI_END, 0, G);
    }
    if (IN(3)) SEAM(3);
    if (IN(4) && !DIS_G3) {
        pg8::Gemm g{(const bf16_t*)(ws + WS_XB), (const bf16_t*)(ws + WS_W3), MT, 2 * DFF, DM}; pg8::StaticOrder S; S.init(MT, 2 * DFF, G, (int)blockIdx.x);
        pg8::Epi3 E{(bf16_t*)(ws + WS_H), (const float*)(ws + WS_SSQ1)};
        pg8::gemm_phase<pg8::Epi3, pg8::StaticOrder, PG8_ALIGN, PG8_SP2>((LAS unsigned char*)lds, g, S, E);
    }
    if (IN(4)) SEAM(4);
    if (IN(5) && !DIS_G4) {
        { pg8::Gemm g{(const bf16_t*)(ws + WS_H), (const bf16_t*)(ws + WS_W4), MP, DM, DFF}; pg8::StaticOrder S; S.init(MP, DM, G, (int)blockIdx.x);
          pg8::Epi4N E{p.out, (const bf16_t*)(ws + WS_XB), p.in[23], (float*)(ws + WS_SLOT), (unsigned*)(ws + WS_PCNT), (LAS unsigned char*)lds + 131072};
          pg8::gemm_phase<pg8::Epi4N, pg8::StaticOrder, PG8_ALIGN, PG8_SP2>((LAS unsigned char*)lds, g, S, E); }
        for (int pc = (int)blockIdx.x; pc < 88; pc += G) { const int ks = pc % 11, un = pc / 11;
          pg8::Gemm g{(const bf16_t*)(ws + WS_H) + ks * 256, (const bf16_t*)(ws + WS_W4) + ks * 256, MT, DM, 256, DFF}; pg8::OneUnit S{256 + un / 4, un % 4};
          pg8::Epi4P E{(float*)(ws + WS_PART) + (size_t)ks * MS * DM};
          pg8::gemm_phase<pg8::Epi4P, pg8::OneUnit, false, PG8_SP2>((LAS unsigned char*)lds, g, S, E); }
    }
#endif
    SEAM(5);
    if (IN(6)) { final_norm(p, tid, G); }
#undef IN
#undef SEAM
}

extern "C" void kernel_launch(void* const* d_in, const int* in_sizes, int n_in, void* d_out, int out_size, void* d_ws, size_t ws_size, hipStream_t stream) {
    static int grid = 0;
    if (grid == 0) {
        if (n_in != 24 || (size_t)out_size != pg8::EO_END || ws_size < WS_END) { fprintf(stderr, "kernel_launch: unexpected shapes: n_in %d out %d ws %zu\n", n_in, out_size, ws_size); grid = -1; return; }
        int dev = 0, cus = 0, per_cu = 0;
        hipGetDevice(&dev); hipDeviceGetAttribute(&cus, hipDeviceAttributeMultiprocessorCount, dev);
        if (hipFuncSetAttribute((const void*)mega_fwd, hipFuncAttributeMaxDynamicSharedMemorySize, LDS_BYTES) != hipSuccess) { fprintf(stderr, "kernel_launch: hipFuncSetAttribute failed\n"); grid = -1; return; }
        if (hipOccupancyMaxActiveBlocksPerMultiprocessor(&per_cu, (const void*)mega_fwd, NTHR, LDS_BYTES) != hipSuccess || per_cu < 1) { fprintf(stderr, "kernel_launch: occupancy query says %d\n", per_cu); per_cu = 1; }
        (void)hipGetLastError();
        grid = cus * 1;
        fprintf(stderr, "kernel_launch: grid %d (cus %d, per_cu %d)\n", grid, cus, per_cu);
    }
    if (grid < 0) return;
    Params p{};
    for (int i = 0; i < 24; ++i) p.in[i] = (const float*)d_in[i];
    p.out = (float*)d_out; p.ws = (unsigned char*)d_ws;
#if defined(MK_MULTI)
    for (int ph = 0; ph < 7; ++ph) { int lo = ph, hi = ph + 1; void* args[] = {&p, &lo, &hi};
        hipError_t e = hipLaunchCooperativeKernel((void*)mega_fwd, dim3(grid), dim3(NTHR), args, LDS_BYTES, stream);
        if (e != hipSuccess) fprintf(stderr, "launch %d failed: %s\n", ph, hipGetErrorString(e)); }
#else
    int lo = 0, hi = 7; void* args[] = {&p, &lo, &hi};
    hipError_t e = hipLaunchCooperativeKernel((void*)mega_fwd, dim3(grid), dim3(NTHR), args, LDS_BYTES, stream);
    if (e != hipSuccess) fprintf(stderr, "cooperative launch failed: %s (grid %d)\n", hipGetErrorString(e), grid);
#endif
}
```

```cpp
#include <hip/hip_runtime.h>
#include <hip/hip_cooperative_groups.h>
#include <cstdio>
#include <cstdint>
#include <cmath>
namespace cg = cooperative_groups;
__device__ __forceinline__ float xr16_max(float m) { auto r = __builtin_amdgcn_permlane16_swap(__float_as_uint(m), __float_as_uint(m), false, false); return fmaxf(__uint_as_float(r[0]), __uint_as_float(r[1])); }
__device__ __forceinline__ float xr32_max(float m) { auto r = __builtin_amdgcn_permlane32_swap(__float_as_uint(m), __float_as_uint(m), false, false); return fmaxf(__uint_as_float(r[0]), __uint_as_float(r[1])); }
__device__ __forceinline__ float xr16_sum(float m) { auto r = __builtin_amdgcn_permlane16_swap(__float_as_uint(m), __float_as_uint(m), false, false); return __uint_as_float(r[0]) + __uint_as_float(r[1]); }
__device__ __forceinline__ float xr32_sum(float m) { auto r = __builtin_amdgcn_permlane32_swap(__float_as_uint(m), __float_as_uint(m), false, false); return __uint_as_float(r[0]) + __uint_as_float(r[1]); }
__device__ __forceinline__ float rows_max(float m) { return xr32_max(xr16_max(m)); }
__device__ __forceinline__ float rows_sum(float m) { return xr32_sum(xr16_sum(m)); }
namespace pg8 {
#define PG8_LAS __attribute__((address_space(3)))
typedef unsigned short bf16_t;
typedef short bf16x8 __attribute__((ext_vector_type(8)));
typedef float f32x4 __attribute__((ext_vector_type(4)));
typedef unsigned u32x4 __attribute__((ext_vector_type(4)));
constexpr int BM = 256, BK = 64, HALF = 128, HTB = HALF * BK * 2  , STAGE_BYTES = 8 * HTB, NXCD = 8, WGM = 8;

__host__ __device__ __forceinline__ int lds_byte(int r, int c) { const int st = (r >> 4) * 2 + (c >> 5), rr = r & 15, cc = c & 31, ob = rr * 64 + cc * 2; return st * 1024 + (ob ^ (((ob >> 9) & 1) << 5)); }
__host__ __device__ __forceinline__ void stage_rc(int b, int& R, int& C) { const int st = b / 1024, sb = b % 1024, swz = sb ^ (((sb >> 9) & 1) << 5); R = (st >> 1) * 16 + swz / 64; C = (st & 1) * 32 + (swz % 64) / 2; }
__host__ __device__ __forceinline__ int perm32(int rho) { const int n = rho >> 4, i = rho & 15; return 8 * (i >> 2) + 4 * n + (i & 3); }

struct Unit { int pm, pn; };
struct Gemm { const bf16_t* A; const bf16_t* Bt; int M, N, K; int ld = 0; };

struct StaticOrder {
    int nM, nN, nwg, G, c;
    __host__ __device__ void init(int M, int N, int G_, int c_) { nM = M / BM; nN = N / BM; nwg = nM * nN; G = G_; c = c_; }
    __host__ __device__ bool next(int i, Unit& u) const {
        const long L = (long)i * G + c; if (L >= nwg) return false;
        int wgid = (int)L; { const int q = nwg / NXCD, r = nwg % NXCD, xcd = wgid % NXCD, off = wgid / NXCD; wgid = (xcd < r ? xcd * (q + 1) : r * (q + 1) + (xcd - r) * q) + off; }
        const int nig = WGM * nN, gid = wgid / nig, fm = gid * WGM, gsz = (nM - fm) < WGM ? (nM - fm) : WGM;
        u.pm = fm + ((wgid % nig) % gsz); u.pn = (wgid % nig) / gsz; return true;
    }
    __device__ __forceinline__ void a_ready(const Unit&) const {}
    __device__ __forceinline__ void done(const Unit&) const {}
};

struct OneUnit {
    int pm, pn;
    __device__ __forceinline__ bool next(int i, Unit& u) const { if (i) return false; u.pm = pm; u.pn = pn; return true; }
    __device__ __forceinline__ void a_ready(const Unit&) const {}
    __device__ __forceinline__ void done(const Unit&) const {}
};
__device__ __forceinline__ unsigned cvt_pk_bf16(float lo, float hi) { unsigned r; asm volatile("v_cvt_pk_bf16_f32 %0, %1, %2" : "=v"(r) : "v"(lo), "v"(hi)); return r; }

constexpr int E_DM = 1024, E_INC = 2560, E_DFF = 2816, E_MP = 65536;
constexpr size_t EO_YS = (size_t)65536 * 1024, EO_PCONV = EO_YS + 512 * 1024, EO_PLRU = EO_PCONV + 32 * 3 * 512, EO_PK = EO_PLRU + 32 * 512, EO_PV = EO_PK + (size_t)32 * 512 * 512,
                 EO_SCONV = EO_PV + (size_t)32 * 512 * 512, EO_SLRU = EO_SCONV + 32 * 3 * 512, EO_SK = EO_SLRU + 32 * 512, EO_SV = EO_SK + 32 * 16 * 512, EO_END = EO_SV + 32 * 16 * 512;
constexpr float E_EPS = 1e-6f;

struct Epi1 {
    static constexpr bool PERM = true, AFTER_DRAIN = false, MIDSCALE = false; static constexpr int MID_T = 0;
    bf16_t* P; const float* rs1; float* out;
    __device__ __forceinline__ void mid(f32x4 (&acc)[2][2][4][2], const Unit& u, int wr, int fr, int ui) const {}
    __device__ __forceinline__ void operator()(const f32x4 (&acc)[2][2][4][2], const Unit& u, int wr, int wc, int fr, int fq, int ui) const {
        const int row0 = u.pm * BM + wr * 64 + fr, colb = u.pn * BM + wc * 32 + 8 * fq;
        const bool samp = u.pm >= 256;
        const bool kv = u.pn >= 6 && (samp || (u.pm & 7) >= 6);
        const bool cv = u.pn < 2 && (samp || (u.pm & 7) == 7);
#pragma unroll
        for (int ai = 0; ai < 2; ++ai)
#pragma unroll
            for (int m = 0; m < 4; ++m) {
                const int row = row0 + ai * HALF + m * 16;
#pragma unroll
                for (int bj = 0; bj < 2; ++bj) {
                    const int col = colb + bj * HALF;
                    const f32x4 v0 = acc[ai][bj][m][0], v1 = acc[ai][bj][m][1];
                    u32x4 w; w.x = cvt_pk_bf16(v0[0], v0[1]); w.y = cvt_pk_bf16(v0[2], v0[3]); w.z = cvt_pk_bf16(v1[0], v1[1]); w.w = cvt_pk_bf16(v1[2], v1[3]);
                    *(u32x4*)(P + (size_t)row * E_INC + col) = w;
                    if (kv) {
                        const bool isv = u.pn >= 8; const int c = col - (isv ? 2048 : 1536);
                        float* dst;
                        if (samp) dst = out + (isv ? EO_SV : EO_SK) + (size_t)(row - E_MP) * 512 + c;
                        else { const int b = row >> 11, t = row & 2047; dst = out + (isv ? EO_PV : EO_PK) + ((size_t)(b * 512 + (t - 1536)) * 512 + c); }
                        *(f32x4*)dst = v0; *(f32x4*)(dst + 4) = v1;
                    }
                    if (cv) {
                        if (samp) { const int b = (row - E_MP) >> 4, t = row & 15; if (t >= 13) { float* dst = out + EO_SCONV + ((size_t)(b * 3 + (t - 13)) * 512 + col); *(f32x4*)dst = v0; *(f32x4*)(dst + 4) = v1; } }
                        else { const int b = row >> 11, t = row & 2047; if (t >= 2045) { float* dst = out + EO_PCONV + ((size_t)(b * 3 + (t - 2045)) * 512 + col); *(f32x4*)dst = v0; *(f32x4*)(dst + 4) = v1; } }
                    }
                }
            }
    }
};

struct Epi2 {
    static constexpr bool PERM = true, AFTER_DRAIN = false, MIDSCALE = true; static constexpr int MID_T = 8;
    const float* xp; const float* xs; float* out; bf16_t* X1B; const PG8_LAS float* tab; float* ssq1;
    __device__ __forceinline__ void mid(f32x4 (&acc)[2][2][4][2], const Unit& u, int wr, int fr, int ui) const {
#pragma unroll
        for (int ai = 0; ai < 2; ++ai)
#pragma unroll
            for (int m = 0; m < 4; ++m) {
                const float rho = tab[(ui * 256 + ai * HALF + wr * 64 + m * 16 + fr) * 2];
#pragma unroll
                for (int bj = 0; bj < 2; ++bj)
#pragma unroll
                    for (int n = 0; n < 2; ++n) acc[ai][bj][m][n] = acc[ai][bj][m][n] * rho;
            }
    }
    __device__ __forceinline__ void operator()(const f32x4 (&acc)[2][2][4][2], const Unit& u, int wr, int wc, int fr, int fq, int ui) const {
        const int row0 = u.pm * BM + wr * 64 + fr, colb = u.pn * BM + wc * 32 + 8 * fq;
        const float* xbase = u.pm >= 256 ? xs - (size_t)E_MP * E_DM : xp;
#pragma unroll
        for (int ai = 0; ai < 2; ++ai)
#pragma unroll
            for (int m = 0; m < 4; ++m) {
                const int row = row0 + ai * HALF + m * 16;
                const float rsa = tab[(ui * 256 + ai * HALF + wr * 64 + m * 16 + fr) * 2 + 1];
                float ss = 0.f;
#pragma unroll
                for (int bj = 0; bj < 2; ++bj) {
                    const size_t off = (size_t)row * E_DM + colb + bj * HALF;
                    const f32x4 x0 = *(const f32x4*)(xbase + off), x1 = *(const f32x4*)(xbase + off + 4);
                    const f32x4 v0 = x0 + acc[ai][bj][m][0] * rsa, v1 = x1 + acc[ai][bj][m][1] * rsa;
                    if (u.pm >= 256) { *(f32x4*)(out + off) = v0; *(f32x4*)(out + off + 4) = v1; }
                    u32x4 w; w.x = cvt_pk_bf16(v0[0], v0[1]); w.y = cvt_pk_bf16(v0[2], v0[3]); w.z = cvt_pk_bf16(v1[0], v1[1]); w.w = cvt_pk_bf16(v1[2], v1[3]);
                    *(u32x4*)(X1B + off) = w;
                    ss += (v0[0] * v0[0] + v0[1] * v0[1]) + (v0[2] * v0[2] + v0[3] * v0[3]) + (v1[0] * v1[0] + v1[1] * v1[1]) + (v1[2] * v1[2] + v1[3] * v1[3]);
                }
                ss = rows_sum(ss);
                if (fq == 0) atomicAdd(ssq1 + row, ss);
            }
    }
};

struct Epi3 {
    static constexpr bool PERM = true, AFTER_DRAIN = false, MIDSCALE = false; static constexpr int MID_T = 0;
    bf16_t* H; const float* ssq1;
    __device__ __forceinline__ void mid(f32x4 (&acc)[2][2][4][2], const Unit& u, int wr, int fr, int ui) const {}
    __device__ __forceinline__ void operator()(const f32x4 (&acc)[2][2][4][2], const Unit& u, int wr, int wc, int fr, int fq, int ui) const {
        const int row0 = u.pm * BM + wr * 64 + fr, col = u.pn * HALF + wc * 32 + 8 * fq;
#pragma unroll
        for (int ai = 0; ai < 2; ++ai)
#pragma unroll
            for (int m = 0; m < 4; ++m) {
                const int row = row0 + ai * HALF + m * 16;
                const float rs = __builtin_amdgcn_rsqf(ssq1[row] * (1.f / 1024.f) + E_EPS);
                const float rsc = -1.44269504f * rs, rs2 = rs * rs;
                float hv[8];
#pragma unroll
                for (int n = 0; n < 2; ++n) {
                    const f32x4 G = acc[ai][0][m][n], U = acc[ai][1][m][n];
                    const f32x4 E = G * rsc;
                    f32x4 D = {__builtin_amdgcn_exp2f(E[0]), __builtin_amdgcn_exp2f(E[1]), __builtin_amdgcn_exp2f(E[2]), __builtin_amdgcn_exp2f(E[3])};
                    D = D + 1.0f;
                    const f32x4 R = {__builtin_amdgcn_rcpf(D[0]), __builtin_amdgcn_rcpf(D[1]), __builtin_amdgcn_rcpf(D[2]), __builtin_amdgcn_rcpf(D[3])};
                    const f32x4 Hv = ((G * U) * rs2) * R;
                    hv[n * 4 + 0] = Hv[0]; hv[n * 4 + 1] = Hv[1]; hv[n * 4 + 2] = Hv[2]; hv[n * 4 + 3] = Hv[3];
                }
                u32x4 w; w.x = cvt_pk_bf16(hv[0], hv[1]); w.y = cvt_pk_bf16(hv[2], hv[3]); w.z = cvt_pk_bf16(hv[4], hv[5]); w.w = cvt_pk_bf16(hv[6], hv[7]);
                *(u32x4*)(H + (size_t)row * E_DFF + col) = w;
            }
    }
};

struct Epi4N {
    static constexpr bool PERM = true, AFTER_DRAIN = false, MIDSCALE = false; static constexpr int MID_T = 0;
    float* out; const bf16_t* X1B; const float* gfin; float* slots; unsigned* cnt; PG8_LAS unsigned char* xl;
    __device__ __forceinline__ void mid(f32x4 (&acc)[2][2][4][2], const Unit& u, int wr, int fr, int ui) const {}
    __device__ __forceinline__ void operator()(const f32x4 (&acc)[2][2][4][2], const Unit& u, int wr, int wc, int fr, int fq, int ui) const {
        const int row0 = u.pm * BM + wr * 64 + fr, colb = u.pn * BM + wc * 32 + 8 * fq;
        PG8_LAS float* P = (PG8_LAS float*)xl; PG8_LAS float* S = (PG8_LAS float*)(xl + 4096);
        int tid_ = threadIdx.x; asm volatile("" : "+v"(tid_)); const int tid = tid_;
        f32x4 v[2][4][2][2];
#pragma unroll
        for (int ai = 0; ai < 2; ++ai)
#pragma unroll
            for (int m = 0; m < 4; ++m) {
                const int row = row0 + ai * HALF + m * 16; float ss = 0.f;
#pragma unroll
                for (int bj = 0; bj < 2; ++bj) {
                    const size_t off = (size_t)row * E_DM + colb + bj * HALF;
                    const u32x4 xb = *(const u32x4*)(X1B + off);
                    const f32x4 v0 = (f32x4){__uint_as_float(xb.x << 16), __uint_as_float(xb.x & 0xffff0000u), __uint_as_float(xb.y << 16), __uint_as_float(xb.y & 0xffff0000u)} + acc[ai][bj][m][0];
                    const f32x4 v1 = (f32x4){__uint_as_float(xb.z << 16), __uint_as_float(xb.z & 0xffff0000u), __uint_as_float(xb.w << 16), __uint_as_float(xb.w & 0xffff0000u)} + acc[ai][bj][m][1];
                    v[ai][m][bj][0] = v0; v[ai][m][bj][1] = v1;
                    ss += (v0[0] * v0[0] + v0[1] * v0[1]) + (v0[2] * v0[2] + v0[3] * v0[3]) + (v1[0] * v1[0] + v1[1] * v1[1]) + (v1[2] * v1[2] + v1[3] * v1[3]);
                }
                ss = rows_sum(ss);
                if (fq == 0) P[(ai * HALF + wr * 64 + m * 16 + fr) * 4 + wc] = ss;
            }
        asm volatile("s_waitcnt lgkmcnt(0)" ::: "memory"); __builtin_amdgcn_s_barrier(); asm volatile("" ::: "memory");
        if (tid < 256) { const float tot = (P[tid * 4] + P[tid * 4 + 1]) + (P[tid * 4 + 2] + P[tid * 4 + 3]);
            __hip_atomic_store(slots + ((size_t)(u.pm * BM + tid)) * 4 + u.pn, tot, __ATOMIC_RELAXED, __HIP_MEMORY_SCOPE_AGENT); }
        asm volatile("s_waitcnt vmcnt(0)" ::: "memory"); __builtin_amdgcn_s_barrier(); asm volatile("" ::: "memory");
        if (tid == 0) {
            __hip_atomic_fetch_add(cnt + 64 * u.pm, 1u, __ATOMIC_RELAXED, __HIP_MEMORY_SCOPE_AGENT);
            unsigned spins = 0; while (__hip_atomic_load(cnt + 64 * u.pm, __ATOMIC_RELAXED, __HIP_MEMORY_SCOPE_AGENT) < 4u && ++spins < (1u << 20)) __builtin_amdgcn_s_sleep(2);
        }
        asm volatile("s_waitcnt vmcnt(0) lgkmcnt(0)" ::: "memory"); __builtin_amdgcn_s_barrier(); asm volatile("" ::: "memory");
        if (tid < 256) { const float* sl = slots + ((size_t)(u.pm * BM + tid)) * 4;
            const float tot = (__hip_atomic_load(sl, __ATOMIC_RELAXED, __HIP_MEMORY_SCOPE_AGENT) + __hip_atomic_load(sl + 1, __ATOMIC_RELAXED, __HIP_MEMORY_SCOPE_AGENT))
                            + (__hip_atomic_load(sl + 2, __ATOMIC_RELAXED, __HIP_MEMORY_SCOPE_AGENT) + __hip_atomic_load(sl + 3, __ATOMIC_RELAXED, __HIP_MEMORY_SCOPE_AGENT));
            S[tid] = __builtin_amdgcn_rsqf(tot * (1.f / 1024.f) + E_EPS); }
        asm volatile("s_waitcnt vmcnt(0) lgkmcnt(0)" ::: "memory"); __builtin_amdgcn_s_barrier(); asm volatile("" ::: "memory");
        f32x4 gg[2][2];
#pragma unroll
        for (int bj = 0; bj < 2; ++bj) { gg[bj][0] = *(const f32x4*)(gfin + colb + bj * HALF); gg[bj][1] = *(const f32x4*)(gfin + colb + bj * HALF + 4); }
#pragma unroll
        for (int ai = 0; ai < 2; ++ai)
#pragma unroll
            for (int m = 0; m < 4; ++m) {
                const int row = row0 + ai * HALF + m * 16; const float rs = S[ai * HALF + wr * 64 + m * 16 + fr];
#pragma unroll
                for (int bj = 0; bj < 2; ++bj) { const size_t off = (size_t)row * E_DM + colb + bj * HALF;
                    *(f32x4*)(out + off) = v[ai][m][bj][0] * rs * gg[bj][0]; *(f32x4*)(out + off + 4) = v[ai][m][bj][1] * rs * gg[bj][1]; }
            }
        asm volatile("s_waitcnt lgkmcnt(0)" ::: "memory"); __builtin_amdgcn_s_barrier(); asm volatile("" ::: "memory");
    }
};

struct Epi4P {
    static constexpr bool PERM = true, AFTER_DRAIN = false, MIDSCALE = false; static constexpr int MID_T = 0;
    float* part;
    __device__ __forceinline__ void mid(f32x4 (&acc)[2][2][4][2], const Unit& u, int wr, int fr, int ui) const {}
    __device__ __forceinline__ void operator()(const f32x4 (&acc)[2][2][4][2], const Unit& u, int wr, int wc, int fr, int fq, int ui) const {
        const int row0 = (u.pm - 256) * BM + wr * 64 + fr, colb = u.pn * BM + wc * 32 + 8 * fq;
#pragma unroll
        for (int ai = 0; ai < 2; ++ai)
#pragma unroll
            for (int m = 0; m < 4; ++m)
#pragma unroll
                for (int bj = 0; bj < 2; ++bj) { float* dst = part + (size_t)(row0 + ai * HALF + m * 16) * E_DM + colb + bj * HALF; *(f32x4*)dst = acc[ai][bj][m][0]; *(f32x4*)(dst + 4) = acc[ai][bj][m][1]; }
    }
};

struct Epi4 {
    static constexpr bool PERM = true, AFTER_DRAIN = false, MIDSCALE = false; static constexpr int MID_T = 0;
    float* out; float* ssq2;
    __device__ __forceinline__ void mid(f32x4 (&acc)[2][2][4][2], const Unit& u, int wr, int fr, int ui) const {}
    __device__ __forceinline__ void operator()(const f32x4 (&acc)[2][2][4][2], const Unit& u, int wr, int wc, int fr, int fq, int ui) const {
        const int row0 = u.pm * BM + wr * 64 + fr, colb = u.pn * BM + wc * 32 + 8 * fq;
#pragma unroll
        for (int ai = 0; ai < 2; ++ai)
#pragma unroll
            for (int m = 0; m < 4; ++m) {
                const int row = row0 + ai * HALF + m * 16;
                float ss = 0.f;
#pragma unroll
                for (int bj = 0; bj < 2; ++bj) {
                    const size_t off = (size_t)row * E_DM + colb + bj * HALF;
                    const f32x4 x0 = *(const f32x4*)(out + off), x1 = *(const f32x4*)(out + off + 4);
                    const f32x4 v0 = x0 + acc[ai][bj][m][0], v1 = x1 + acc[ai][bj][m][1];
                    *(f32x4*)(out + off) = v0; *(f32x4*)(out + off + 4) = v1;
                    ss += (v0[0] * v0[0] + v0[1] * v0[1]) + (v0[2] * v0[2] + v0[3] * v0[3]) + (v1[0] * v1[0] + v1[1] * v1[1]) + (v1[2] * v1[2] + v1[3] * v1[3]);
                }
                ss = rows_sum(ss);
                if (fq == 0) atomicAdd(ssq2 + row, ss);
            }
    }
};

template <class Epi, class Sched, bool ALIGN_EPI = false, bool SP2 = false>
__device__ __forceinline__ void gemm_phase(PG8_LAS unsigned char* lds, const Gemm g, const Sched& S, const Epi& E) {
    const int tid = threadIdx.x, wid = __builtin_amdgcn_readfirstlane(tid >> 6), lane = tid & 63, wr = wid >> 2, wc = wid & 3, fr = lane & 15, fq = lane >> 4;
    const int K = g.ld ? g.ld : g.K, nt = g.K / BK;
    unsigned voffA[2], voffB[2];
#pragma unroll
    for (int i = 0; i < 2; ++i) { int R, C; stage_rc(tid * 16 + i * 8192, R, C); const int Rb = Epi::PERM ? ((R & ~31) + perm32(R & 31)) : R;
        voffA[i] = (unsigned)(R * K + C) * 2u; voffB[i] = (unsigned)(Rb * K + C) * 2u; }
    const size_t kstep = (size_t)(BK * 2);
    const size_t hstep = (size_t)HALF * K * 2;
    const size_t tstep = 2 * hstep;
    const unsigned ldsw = (unsigned)wid * 1024u;
    const int aoff = lds_byte(wr * 64 + fr, fq * 8), boff = lds_byte(wc * 32 + fr, fq * 8);
#define PG8_SA(b, h) (((b) * 2 + (h)) * HTB)
#define PG8_SB(b, h) ((4 + (b) * 2 + (h)) * HTB)
#define PG8_STAGE(bufoff, gbase, voff) do { _Pragma("unroll") for (int _i = 0; _i < 2; ++_i) \
        __builtin_amdgcn_global_load_lds((const unsigned*)((const char*)(gbase) + (voff)[_i]), (PG8_LAS unsigned*)(lds + (bufoff) + ldsw + _i * 8192), 16, 0, 0); } while (0)
#define PG8_LDA(dst, b, h) do { _Pragma("unroll") for (int m = 0; m < 4; ++m) _Pragma("unroll") for (int k = 0; k < 2; ++k) dst[m][k] = *(const PG8_LAS bf16x8*)(lds + PG8_SA(b, h) + aoff + m * 2048 + k * 1024); } while (0)
#define PG8_LDB(dst, b, h) do { _Pragma("unroll") for (int n = 0; n < 2; ++n) _Pragma("unroll") for (int k = 0; k < 2; ++k) dst[n][k] = *(const PG8_LAS bf16x8*)(lds + PG8_SB(b, h) + boff + n * 2048 + k * 1024); } while (0)
#define PG8_MMA(ai, bj, At, Bt) do { __builtin_amdgcn_s_setprio(1); _Pragma("unroll") for (int m = 0; m < 4; ++m) _Pragma("unroll") for (int n = 0; n < 2; ++n) _Pragma("unroll") for (int k = 0; k < 2; ++k) \
        acc[ai][bj][m][n] = __builtin_amdgcn_mfma_f32_16x16x32_bf16(Bt[n][k], At[m][k], acc[ai][bj][m][n], 0, 0, 0); __builtin_amdgcn_s_setprio(0); } while (0)
#define PG8_WAIT_V(n) asm volatile("s_waitcnt vmcnt(" #n ")" ::: "memory")
#define PG8_WAIT_L(n) asm volatile("s_waitcnt lgkmcnt(" #n ")" ::: "memory")
#define PG8_BAR __builtin_amdgcn_s_barrier()
#define PG8_SCHED __builtin_amdgcn_sched_barrier(0)
    Unit cur, nxt; int ui = 0;
    if (!S.next(0, cur)) return;
    f32x4 acc[2][2][4][2];
#pragma unroll
    for (int a = 0; a < 2; ++a)
#pragma unroll
        for (int b = 0; b < 2; ++b)
#pragma unroll
            for (int m = 0; m < 4; ++m)
#pragma unroll
                for (int n = 0; n < 2; ++n) acc[a][b][m][n] = (f32x4){0.f, 0.f, 0.f, 0.f};
    bf16x8 At[4][2], B0[2][2], B1[2][2];
    const char* cA = (const char*)g.A + (size_t)cur.pm * tstep; const char* cB = (const char*)g.Bt + (size_t)cur.pn * tstep;
    S.a_ready(cur);
    if constexpr (SP2) {
        PG8_STAGE(PG8_SB(0, 0), cB, voffB); PG8_STAGE(PG8_SB(0, 1), cB + hstep, voffB); PG8_STAGE(PG8_SA(0, 0), cA, voffA); PG8_STAGE(PG8_SA(0, 1), cA + hstep, voffA);
        if (wr == 1) PG8_BAR;
        PG8_WAIT_V(2); PG8_BAR;
        PG8_STAGE(PG8_SB(1, 0), cB + kstep, voffB); PG8_STAGE(PG8_SA(1, 0), cA + kstep, voffA); PG8_STAGE(PG8_SB(1, 1), cB + hstep + kstep, voffB);
        PG8_WAIT_V(6); PG8_BAR;
    } else {
        PG8_STAGE(PG8_SB(0, 0), cB, voffB); PG8_STAGE(PG8_SA(0, 0), cA, voffA); PG8_STAGE(PG8_SB(0, 1), cB + hstep, voffB); PG8_STAGE(PG8_SA(0, 1), cA + hstep, voffA);
        if (wr == 1) PG8_BAR;
        PG8_WAIT_V(4); PG8_BAR;
        PG8_STAGE(PG8_SB(1, 0), cB + kstep, voffB); PG8_STAGE(PG8_SA(1, 0), cA + kstep, voffA); PG8_STAGE(PG8_SB(1, 1), cB + hstep + kstep, voffB);
        PG8_WAIT_V(6); PG8_BAR;
    }
    for (;;) {
        const bool has_next = S.next(ui + 1, nxt);
        const char* nA = has_next ? (const char*)g.A + (size_t)nxt.pm * tstep : cA; const char* nB = has_next ? (const char*)g.Bt + (size_t)nxt.pn * tstep : cB;
        for (int t = 0; t < nt; t += 2) {
            if constexpr (Epi::MIDSCALE) { if (t == Epi::MID_T) E.mid(acc, cur, wr, fr, ui); }
            const bool last = (t == nt - 2);
            const char* a1 = cA + (size_t)(t + 1) * kstep;
            const char* a2 = last ? nA : cA + (size_t)(t + 2) * kstep; const char* b2 = last ? nB : cB + (size_t)(t + 2) * kstep;
            const char* a3 = a2 + kstep; const char* b3 = b2 + kstep;
            if (last && has_next) S.a_ready(nxt);
            if constexpr (SP2) {
            PG8_LDB(B0, 0, 0); PG8_LDB(B1, 0, 1); PG8_SCHED; PG8_LDA(At, 0, 0); PG8_STAGE(PG8_SA(1, 1), a1 + hstep, voffA);
            PG8_WAIT_V(8); PG8_WAIT_L(0); PG8_BAR; PG8_MMA(0, 0, At, B0); PG8_MMA(0, 1, At, B1); PG8_BAR; PG8_SCHED;
            PG8_LDA(At, 0, 1); PG8_STAGE(PG8_SB(0, 0), b2, voffB); PG8_STAGE(PG8_SB(0, 1), b2 + hstep, voffB); PG8_STAGE(PG8_SA(0, 0), a2, voffA);
            PG8_WAIT_V(8); PG8_WAIT_L(0); PG8_BAR; PG8_MMA(1, 0, At, B0); PG8_MMA(1, 1, At, B1); PG8_BAR; PG8_SCHED;
            PG8_LDB(B0, 1, 0); PG8_LDB(B1, 1, 1); PG8_SCHED; PG8_LDA(At, 1, 0); PG8_STAGE(PG8_SA(0, 1), a2 + hstep, voffA);
            PG8_WAIT_V(8); PG8_WAIT_L(0); PG8_BAR; PG8_MMA(0, 0, At, B0); PG8_MMA(0, 1, At, B1); PG8_BAR; PG8_SCHED;
            PG8_LDA(At, 1, 1); PG8_STAGE(PG8_SB(1, 0), b3, voffB); PG8_STAGE(PG8_SB(1, 1), b3 + hstep, voffB); PG8_STAGE(PG8_SA(1, 0), a3, voffA);
            PG8_WAIT_V(8); PG8_WAIT_L(0); PG8_BAR; PG8_MMA(1, 0, At, B0); PG8_MMA(1, 1, At, B1); PG8_BAR; PG8_SCHED;
            } else {
            PG8_LDB(B0, 0, 0); PG8_SCHED; PG8_LDA(At, 0, 0); PG8_STAGE(PG8_SA(1, 1), a1 + hstep, voffA);
            PG8_WAIT_L(8); PG8_BAR; PG8_WAIT_L(0); PG8_MMA(0, 0, At, B0); PG8_BAR; PG8_SCHED;
            PG8_LDB(B1, 0, 1); PG8_STAGE(PG8_SB(0, 0), b2, voffB);
            PG8_BAR; PG8_WAIT_L(0); PG8_MMA(0, 1, At, B1); PG8_BAR;
            PG8_LDA(At, 0, 1); PG8_STAGE(PG8_SA(0, 0), a2, voffA);
            PG8_BAR; PG8_WAIT_L(0); PG8_MMA(1, 0, At, B0); PG8_BAR; PG8_SCHED;
            PG8_STAGE(PG8_SB(0, 1), b2 + hstep, voffB);
            PG8_WAIT_V(6); PG8_BAR; PG8_MMA(1, 1, At, B1); PG8_BAR;
            PG8_LDB(B0, 1, 0); PG8_SCHED; PG8_LDA(At, 1, 0); PG8_STAGE(PG8_SA(0, 1), a2 + hstep, voffA);
            PG8_WAIT_L(8); PG8_BAR; PG8_WAIT_L(0); PG8_MMA(0, 0, At, B0); PG8_BAR; PG8_SCHED;
            PG8_LDB(B1, 1, 1); PG8_STAGE(PG8_SB(1, 0), b3, voffB);
            PG8_BAR; PG8_WAIT_L(0); PG8_MMA(0, 1, At, B1); PG8_BAR;
            PG8_LDA(At, 1, 1); PG8_STAGE(PG8_SA(1, 0), a3, voffA);
            PG8_BAR; PG8_WAIT_L(0); PG8_MMA(1, 0, At, B0); PG8_BAR; PG8_SCHED;
            PG8_STAGE(PG8_SB(1, 1), b3 + hstep, voffB);
            PG8_WAIT_V(6); PG8_BAR; PG8_MMA(1, 1, At, B1); PG8_BAR;
            }
        }
        if constexpr (ALIGN_EPI) { if (wr == 0) PG8_BAR; }
        if constexpr (!Epi::AFTER_DRAIN) { E(acc, cur, wr, wc, fr, fq, ui); S.done(cur); }
        if (!has_next) break;
#pragma unroll
        for (int a = 0; a < 2; ++a)
#pragma unroll
            for (int b = 0; b < 2; ++b)
#pragma unroll
                for (int m = 0; m < 4; ++m)
#pragma unroll
                    for (int n = 0; n < 2; ++n) acc[a][b][m][n] = (f32x4){0.f, 0.f, 0.f, 0.f};
        cur = nxt; cA = nA; cB = nB; ++ui;
        if constexpr (ALIGN_EPI) { if (wr == 1) PG8_BAR; }
    }
    PG8_WAIT_V(0);
    if constexpr (!ALIGN_EPI) { if (wr == 0) PG8_BAR; }
    PG8_BAR;
    if constexpr (Epi::AFTER_DRAIN) { E.fused(acc, cur, wr, wc, fr, fq, lds, wid, lane); S.done(cur); }
#undef PG8_SA
#undef PG8_SB
#undef PG8_STAGE
#undef PG8_LDA
#undef PG8_LDB
#undef PG8_MMA
#undef PG8_WAIT_V
#undef PG8_WAIT_L
#undef PG8_BAR
#undef PG8_SCHED
}
}

#ifndef PG8_SP2
#define PG8_SP2 true
#endif
#ifndef PG8_ALIGN
#define PG8_ALIGN true
#endif

#define LAS __attribute__((address_space(3)))
typedef unsigned short bf16_t;
typedef short bf16x8 __attribute__((ext_vector_type(8)));
typedef short s16x4 __attribute__((ext_vector_type(4)));
typedef float f32x4 __attribute__((ext_vector_type(4)));
typedef unsigned u32x4 __attribute__((ext_vector_type(4)));
typedef unsigned u32x2 __attribute__((ext_vector_type(2)));

constexpr int NWAVES = 8, NTHR = 512;
constexpr int DM = 1024, SEQ = 2048, NB = 32, DSEQ = 16, LW = 512, NH = 8, HD = 64, DFF = 2816, INC = 2560;
constexpr int MP = NB * SEQ, MS = NB * DSEQ, MT = MP + MS;
constexpr float EPS = 1e-6f, LOG2E = 1.4426950408889634f;
constexpr int LDS_BYTES = 147456;

constexpr size_t MiB = 1u << 20;
constexpr size_t WS_CTR = 3 * (1u << 20);
constexpr size_t WS_PCNT = 3 * (1u << 20) + 131072;
constexpr size_t WS_BAR = 3 * (1u << 20) + 65536;
constexpr size_t WS_SSQL = 0, WS_SSQA = 512 * 1024, WS_SSQ1 = 1024 * 1024, WS_SSQ2 = 1536 * 1024, WS_RS1 = 2 * MiB;
constexpr size_t WS_W1 = 4 * MiB, WS_W2 = 9 * MiB, WS_W3 = 11 * MiB, WS_W4 = 22 * MiB, WS_CK = 28 * MiB, WS_CV = 44 * MiB;
constexpr size_t WS_H = 64 * MiB;
constexpr size_t WS_XB = 420 * MiB;
constexpr size_t WS_Y = 552 * MiB;
constexpr size_t WS_SSQP = 684 * MiB;
constexpr size_t WS_PART = 690 * MiB;
constexpr size_t WS_SLOT = 714 * MiB;
constexpr size_t WS_END = 716 * MiB;

struct Params {
    const float* in[24];
    float* out;
    unsigned char* ws;
};

__device__ __forceinline__ float bf2f(unsigned short b) { return __uint_as_float((unsigned)b << 16); }
__device__ __forceinline__ unsigned pk2(float lo, float hi) { return pg8::cvt_pk_bf16(lo, hi); }
__device__ __forceinline__ float wave_sum(float v) {
#pragma unroll
    for (int o = 1; o < 64; o <<= 1) v += __shfl_xor(v, o);
    return v;
}
__device__ __forceinline__ float fast_sigmoid(float z) { return __builtin_amdgcn_rcpf(1.0f + __builtin_amdgcn_exp2f(-LOG2E * z)); }
__device__ __forceinline__ float gelu_tanh(float x) {
    const float z = 0.7978845608028654f * (x + 0.044715f * x * x * x);
    const float e = __builtin_amdgcn_exp2f(2.0f * LOG2E * z);
    const float th = 1.0f - 2.0f * __builtin_amdgcn_rcpf(e + 1.0f);
    return 0.5f * x * (1.0f + th);
}

__device__ __forceinline__ void p0_transpose_item(const float* W, int K, int N, const float* g0, const float* g1, bf16_t* WT, int dst_row0, int k0, int n0, float* scr, int lane) {
#pragma unroll 8
    for (int i = 0; i < 32; ++i) { const int kk = 2 * i + (lane >> 5); const int k = k0 + kk;
        float sc = 1.f; if (g0) sc = (g1 && k >= 512) ? g1[k - 512] : g0[k];
        scr[kk * 33 + (lane & 31)] = W[(size_t)k * N + n0 + (lane & 31)] * sc; }
    asm volatile("s_waitcnt lgkmcnt(0)" ::: "memory");
    const int c = lane & 7;
#pragma unroll
    for (int j = 0; j < 4; ++j) { const int n = (lane >> 3) + 8 * j; const float* s = scr + (8 * c) * 33 + n;
        u32x4 o; o.x = pk2(s[0 * 33], s[1 * 33]); o.y = pk2(s[2 * 33], s[3 * 33]); o.z = pk2(s[4 * 33], s[5 * 33]); o.w = pk2(s[6 * 33], s[7 * 33]);
        *(u32x4*)(WT + (size_t)(dst_row0 + n0 + n) * K + k0 + 8 * c) = o; }
    asm volatile("s_waitcnt lgkmcnt(0)" ::: "memory");
}

__device__ __forceinline__ void p0_weights(const Params& p, unsigned char* lds, int tid, int lo, int hi, int wg0, int nwg) {
    const int lane = tid & 63, wave = tid >> 6;
    float* scr = (float*)(lds + wave * 16384);
    unsigned char* ws = p.ws;
    bf16_t* W1 = (bf16_t*)(ws + WS_W1); bf16_t* W2 = (bf16_t*)(ws + WS_W2); bf16_t* W3 = (bf16_t*)(ws + WS_W3); bf16_t* W4 = (bf16_t*)(ws + WS_W4);
    constexpr int I1 = 16 * 80, I2 = 16 * 32, I3 = 16 * 88;
    if ((int)blockIdx.x < wg0 || (int)blockIdx.x >= wg0 + nwg) return;
    for (int it = lo + ((int)blockIdx.x - wg0) * NWAVES + wave; it < hi; it += nwg * NWAVES) {
        int r = it;
        if (r < I1) { const int kb = r / 80, nb = r % 80; p0_transpose_item(p.in[7], DM, INC, p.in[6], nullptr, W1, 0, kb * 64, nb * 32, scr, lane); continue; } r -= I1;
        if (r < I2) { const int kb = r / 32, nb = r % 32; p0_transpose_item(p.in[18], DM, DM, p.in[16], p.in[17], W2, 0, kb * 64, nb * 32, scr, lane); continue; } r -= I2;
        if (r < I3) { const int kb = r / 88, nb = r % 88; const int n0 = nb * 32; p0_transpose_item(p.in[20], DM, DFF, p.in[19], nullptr, W3, 256 * (n0 / 128) + (n0 % 128) - n0, kb * 64, n0, scr, lane); continue; } r -= I3;
        if (r < I3) { const int kb = r / 88, nb = r % 88; const int n0 = nb * 32; p0_transpose_item(p.in[21], DM, DFF, p.in[19], nullptr, W3, 256 * (n0 / 128) + 128 + (n0 % 128) - n0, kb * 64, n0, scr, lane); continue; } r -= I3;
        { const int kb = r / 32, nb = r % 32; p0_transpose_item(p.in[22], DFF, DM, nullptr, nullptr, W4, 0, kb * 64, nb * 32, scr, lane); }
    }
}
constexpr int WI_1 = 16 * 80, WI_2 = WI_1 + 16 * 32, WI_END = WI_2 + 2 * 16 * 88 + 44 * 32;
__device__ __forceinline__ void p0_cache(const Params& p, int tid, int wg0, int nwg) {
    if ((int)blockIdx.x < wg0 || (int)blockIdx.x >= wg0 + nwg) return;
    unsigned char* ws = p.ws;
    const int gt = ((int)blockIdx.x - wg0) * NTHR + tid, NGT = nwg * NTHR;
    bf16_t* CK = (bf16_t*)(ws + WS_CK); bf16_t* CV = (bf16_t*)(ws + WS_CV);
    constexpr int NC8 = NB * 512 * 512 / 8;
    for (int i0 = gt; i0 < 2 * NC8; i0 += 4 * NGT) {
        f32x4 a[4], b[4];
#pragma unroll
        for (int u = 0; u < 4; ++u) { const int i = i0 + u * NGT; if (i < 2 * NC8) { const int which = i >= NC8; const int e = (which ? i - NC8 : i);
            const f32x4* src = (const f32x4*)(which ? p.in[5] : p.in[4]) + (size_t)e * 2; a[u] = src[0]; b[u] = src[1]; } }
#pragma unroll
        for (int u = 0; u < 4; ++u) { const int i = i0 + u * NGT; if (i < 2 * NC8) { const int which = i >= NC8; const int e = (which ? i - NC8 : i);
            u32x4 w; w.x = pk2(a[u].x, a[u].y); w.y = pk2(a[u].z, a[u].w); w.z = pk2(b[u].x, b[u].y); w.w = pk2(b[u].z, b[u].w);
            *((u32x4*)(which ? CV : CK) + e) = w; } }
    }
}
__device__ __forceinline__ void p0_prologue(const Params& p, unsigned char* lds, int tid, int G) {
    const int lane = tid & 63, wave = tid >> 6;
    const int gw = blockIdx.x * NWAVES + wave, NGW = G * NWAVES;
    unsigned char* ws = p.ws;
    p0_weights(p, lds, tid, 0, WI_1, 0, G);
    bf16_t* XB = (bf16_t*)(ws + WS_XB); float* rs1 = (float*)(ws + WS_RS1);
    for (int m0 = 4 * gw; m0 < MT; m0 += 4 * NGW) {
        f32x4 v[4][4];
#pragma unroll
        for (int r = 0; r < 4; ++r) { const int m = m0 + r; const float* xrow = m < MP ? p.in[0] + (size_t)m * DM : p.in[1] + (size_t)(m - MP) * DM;
            const f32x4* xr = (const f32x4*)xrow + lane;
#pragma unroll
            for (int j = 0; j < 4; ++j) v[r][j] = xr[64 * j]; }
#pragma unroll
        for (int r = 0; r < 4; ++r) { const int m = m0 + r; float s = 0.f;
#pragma unroll
            for (int j = 0; j < 4; ++j) s += (v[r][j].x * v[r][j].x + v[r][j].y * v[r][j].y) + (v[r][j].z * v[r][j].z + v[r][j].w * v[r][j].w);
            s = wave_sum(s);
            const float rs = __builtin_amdgcn_rsqf(s * (1.f / DM) + EPS);
            u32x2* o8 = (u32x2*)(XB + (size_t)m * DM) + lane;
#pragma unroll
            for (int j = 0; j < 4; ++j) { u32x2 w; w.x = pk2(v[r][j].x * rs, v[r][j].y * rs); w.y = pk2(v[r][j].z * rs, v[r][j].w * rs); o8[64 * j] = w; } }
    }
    const int gt = blockIdx.x * NTHR + tid, NGT = G * NTHR;
    float* z0 = (float*)(ws + WS_SSQL); float* z1 = (float*)(ws + WS_SSQA); float* z2 = (float*)(ws + WS_SSQ1); float* z3 = (float*)(ws + WS_SSQ2);
    for (int i = gt; i < MT; i += NGT) { z2[i] = 0.f; z3[i] = 0.f; }
    if (gt < 8) *((unsigned*)(ws + WS_CTR) + 64 * gt) = 0u;
    for (int i = gt; i < 3456; i += NGT) ((unsigned*)(ws + WS_BAR))[i] = 0u;
    for (int i = gt; i < 256 * 64; i += NGT) ((unsigned*)(ws + WS_PCNT))[i] = 0u;
}

#define LDS_BAR() asm volatile("s_waitcnt lgkmcnt(0)\n\ts_barrier" ::: "memory")
constexpr int L_WA = 0, L_WX = 9216, L_U = 18432, L_UC = 35584, L_UCB = 53248, L_A = 62464, L_BT = 79872, L_SEGA = 97280, L_SEGB = 99328, L_CW = 101376, L_GL = 102656, L_END = 110848;
constexpr int FS = 68;
__device__ __forceinline__ void lru_item(const Params& p, unsigned char* lds, int tid, int b, int n, bool samp, float* ssqL) {
    asm volatile("" : "+v"(tid));
    const int lane = tid & 63, w = tid >> 6, fr = lane & 15, g = lane >> 4;
    unsigned char* ws = p.ws;
    const bf16_t* PROJ = (const bf16_t*)(ws + WS_H); bf16_t* Y = (bf16_t*)(ws + WS_Y);
    const int T = samp ? DSEQ : SEQ;
    const size_t row0 = samp ? (size_t)MP + (size_t)b * DSEQ : (size_t)b * SEQ;
    bf16_t* WA = (bf16_t*)(lds + L_WA); bf16_t* WX = (bf16_t*)(lds + L_WX);
    float* U = (float*)(lds + L_U); float* UC = (float*)(lds + L_UC); bf16_t* UCB = (bf16_t*)(lds + L_UCB);
    float* A = (float*)(lds + L_A); float* BT = (float*)(lds + L_BT); float* SEGA = (float*)(lds + L_SEGA); float* SEGB = (float*)(lds + L_SEGB); float* CW = (float*)(lds + L_CW);
    bf16_t* GL = (bf16_t*)(lds + L_GL);
    const int tr = tid >> 3, c8 = (tid & 7) * 8;
    u32x4 upre = {0u, 0u, 0u, 0u}, gpre = {0u, 0u, 0u, 0u};
    if (tr < T) { const bf16_t* src = PROJ + (row0 + tr) * INC + n * 64 + c8; upre = *(const u32x4*)src; gpre = *(const u32x4*)(src + LW); }
    __syncthreads();
    {
        const int c = tid >> 3, d8 = (tid & 7) * 8;
        const float* wa = p.in[10] + ((size_t)n * 64 + c) * 64 + d8; const float* wx = p.in[12] + ((size_t)n * 64 + c) * 64 + d8;
        const f32x4 a0 = *(const f32x4*)wa, a1 = *(const f32x4*)(wa + 4), x0 = *(const f32x4*)wx, x1 = *(const f32x4*)(wx + 4);
        const float av[8] = {a0.x, a0.y, a0.z, a0.w, a1.x, a1.y, a1.z, a1.w}; const float xv[8] = {x0.x, x0.y, x0.z, x0.w, x1.x, x1.y, x1.z, x1.w};
#pragma unroll
        for (int j = 0; j < 8; ++j) { WA[(d8 + j) * 72 + c] = (bf16_t)(pk2(av[j], 0.f) & 0xffffu); WX[(d8 + j) * 72 + c] = (bf16_t)(pk2(xv[j], 0.f) & 0xffffu); }
        if (tid < 256) CW[tid] = p.in[8][(size_t)(tid >> 6) * LW + n * 64 + (tid & 63)];
        else if (tid < 320) CW[tid] = p.in[9][n * 64 + (tid & 63)];
        if (tid < 192) U[tid] = samp ? p.in[2][((size_t)b * 3 + (tid >> 6)) * LW + n * 64 + (tid & 63)] : 0.f;
    }
    const int mt = w & 3, nh = w >> 2;
    float cba[2], cbx[2], cL[2];
#pragma unroll
    for (int ni = 0; ni < 2; ++ni) { const int d = n * 64 + 32 * nh + 16 * ni + fr; cba[ni] = p.in[11][d]; cbx[ni] = p.in[13][d];
        const float lam = p.in[14][d]; cL[ni] = -8.0f * log1pf(expf(-lam)) * LOG2E; }
    float Hreg = samp ? p.in[3][(size_t)b * LW + n * 64 + lane] : 0.f;
    float hlast = 0.f;
    for (int t0 = 0; t0 < T; t0 += 64) {
        const int tv = (T - t0) < 64 ? (T - t0) : 64;
        { float* dst = U + (3 + tr) * 64 + c8;
          *(f32x4*)dst = (f32x4){__uint_as_float(upre.x << 16), __uint_as_float(upre.x & 0xffff0000u), __uint_as_float(upre.y << 16), __uint_as_float(upre.y & 0xffff0000u)};
          *(f32x4*)(dst + 4) = (f32x4){__uint_as_float(upre.z << 16), __uint_as_float(upre.z & 0xffff0000u), __uint_as_float(upre.w << 16), __uint_as_float(upre.w & 0xffff0000u)};
          *(u32x4*)(GL + tr * 64 + c8) = gpre;
          if (t0 + 64 + tr < T) { const bf16_t* src = PROJ + (row0 + t0 + 64 + tr) * INC + n * 64 + c8; upre = *(const u32x4*)src; gpre = *(const u32x4*)(src + LW); } }
        LDS_BAR();
        { const int t = tr;
          f32x4 o0 = *(const f32x4*)(CW + 256 + c8), o1 = *(const f32x4*)(CW + 256 + c8 + 4);
#pragma unroll
          for (int k = 0; k < 4; ++k) { const f32x4 w0 = *(const f32x4*)(CW + k * 64 + c8), w1 = *(const f32x4*)(CW + k * 64 + c8 + 4);
              const f32x4 u0 = *(const f32x4*)(U + (t + k) * 64 + c8), u1 = *(const f32x4*)(U + (t + k) * 64 + c8 + 4); o0 += w0 * u0; o1 += w1 * u1; }
          *(f32x4*)(UC + t * FS + c8) = o0; *(f32x4*)(UC + t * FS + c8 + 4) = o1;
          u32x4 wv; wv.x = pk2(o0.x, o0.y); wv.y = pk2(o0.z, o0.w); wv.z = pk2(o1.x, o1.y); wv.w = pk2(o1.z, o1.w);
          *(u32x4*)(UCB + t * 72 + c8) = wv; }
        LDS_BAR();
        { bf16x8 af[2];
#pragma unroll
          for (int ks = 0; ks < 2; ++ks) af[ks] = *(const bf16x8*)(UCB + (16 * mt + fr) * 72 + 32 * ks + 8 * g);
#pragma unroll
          for (int ni = 0; ni < 2; ++ni) { const int dl = 32 * nh + 16 * ni + fr;
              f32x4 ca = {0.f, 0.f, 0.f, 0.f}, cx = {0.f, 0.f, 0.f, 0.f};
#pragma unroll
              for (int ks = 0; ks < 2; ++ks) { const bf16x8 ba = *(const bf16x8*)(WA + dl * 72 + 32 * ks + 8 * g), bx = *(const bf16x8*)(WX + dl * 72 + 32 * ks + 8 * g);
                  ca = __builtin_amdgcn_mfma_f32_16x16x32_bf16(af[ks], ba, ca, 0, 0, 0); cx = __builtin_amdgcn_mfma_f32_16x16x32_bf16(af[ks], bx, cx, 0, 0, 0); }
#pragma unroll
              for (int r = 0; r < 4; ++r) { const int t = 16 * mt + 4 * g + r;
                  const float rr = fast_sigmoid(ca[r] + cba[ni]), ii = fast_sigmoid(cx[r] + cbx[ni]);
                  const float a = __builtin_amdgcn_exp2f(rr * cL[ni]);
                  const float gain = __builtin_amdgcn_sqrtf(fmaxf(1.0f - a * a, 0.f));
                  A[t * FS + dl] = a; BT[t * FS + dl] = gain * ii * UC[t * FS + dl]; } } }
        float ucarry = 0.f; if (tid < 192) ucarry = U[(64 + (tid >> 6)) * 64 + (tid & 63)];
        LDS_BAR();
        if (tid < 192) U[tid] = ucarry;
        float hloc[8], cum[8];
        { float hl = 0.f, ca = 1.f;
#pragma unroll
          for (int s = 0; s < 8; ++s) { const int t = 8 * w + s; const float a = A[t * FS + lane], bb = BT[t * FS + lane]; hl = a * hl + bb; ca *= a; hloc[s] = hl; cum[s] = ca; }
          SEGA[w * 64 + lane] = ca; SEGB[w * 64 + lane] = hl; }
        LDS_BAR();
        { float hcur = Hreg, hin = 0.f; const int lastseg = (tv >> 3) - 1;
#pragma unroll
          for (int s = 0; s < 8; ++s) { if (s == w) hin = hcur; hcur = SEGA[s * 64 + lane] * hcur + SEGB[s * 64 + lane]; if (s == lastseg) hlast = hcur; }
          Hreg = hcur;
#pragma unroll
          for (int s = 0; s < 8; ++s) UC[(8 * w + s) * FS + lane] = hloc[s] + cum[s] * hin; }
        LDS_BAR();
        { const f32x4 h0 = *(const f32x4*)(UC + tr * FS + c8), h1 = *(const f32x4*)(UC + tr * FS + c8 + 4);
          const u32x4 gr = *(const u32x4*)(GL + tr * 64 + c8);
          const float y0 = gelu_tanh(__uint_as_float(gr.x << 16)) * h0.x, y1 = gelu_tanh(__uint_as_float(gr.x & 0xffff0000u)) * h0.y;
          const float y2 = gelu_tanh(__uint_as_float(gr.y << 16)) * h0.z, y3 = gelu_tanh(__uint_as_float(gr.y & 0xffff0000u)) * h0.w;
          const float y4 = gelu_tanh(__uint_as_float(gr.z << 16)) * h1.x, y5 = gelu_tanh(__uint_as_float(gr.z & 0xffff0000u)) * h1.y;
          const float y6 = gelu_tanh(__uint_as_float(gr.w << 16)) * h1.z, y7 = gelu_tanh(__uint_as_float(gr.w & 0xffff0000u)) * h1.w;
          float ss = (y0 * y0 + y1 * y1) + (y2 * y2 + y3 * y3) + (y4 * y4 + y5 * y5) + (y6 * y6 + y7 * y7);
          ss += __shfl_xor(ss, 1); ss += __shfl_xor(ss, 2); ss += __shfl_xor(ss, 4);
          if (tr < tv) { u32x4 wv; wv.x = pk2(y0, y1); wv.y = pk2(y2, y3); wv.z = pk2(y4, y5); wv.w = pk2(y6, y7);
              *(u32x4*)(Y + (row0 + t0 + tr) * DM + n * 64 + c8) = wv;
              if ((tid & 7) == 0) ssqL[(row0 + t0 + tr) * 16 + n] = ss; } }
    }
    if (w == 0) p.out[(samp ? pg8::EO_SLRU : pg8::EO_PLRU) + (size_t)b * LW + n * 64 + lane] = hlast;
}

constexpr int VSTR = 128;
constexpr int A_VT = 0, A_Q = 8 * 64 * VSTR, A_TBL = 2 * A_Q, A_END = A_TBL + 8 * 1280;
struct KVSrc { const bf16_t* k; const bf16_t* v; int stride; int nvalid; };
typedef short v4i16_t __attribute__((ext_vector_type(4)));
__device__ __forceinline__ s16x4 vtr(LAS const unsigned char* pp) { return __builtin_bit_cast(s16x4, __builtin_amdgcn_ds_read_tr16_b64_v4i16((LAS v4i16_t*)(pp))); }

template <int NJ, class Src>
__device__ __forceinline__ void attn_item(LAS unsigned char* vlds, LAS const float* tbl, const bf16_t* Q, int qstride, const Src& src, int jt0, int jt1, bf16_t* O, float* ssq, int lane) {
    const int fr = lane & 15, g = lane >> 4;
    bf16x8 qf[NJ][2];
#pragma unroll
    for (int nj = 0; nj < NJ; ++nj)
#pragma unroll
        for (int ks = 0; ks < 2; ++ks) qf[nj][ks] = *(const bf16x8*)((const char*)(Q + (size_t)(16 * nj) * qstride + 32 * ks) + (unsigned)((fr * qstride + 8 * g) * 2));
    f32x4 Oa[4][NJ]; float mrun[NJ], lsum[NJ];
#pragma unroll
    for (int nj = 0; nj < NJ; ++nj) { mrun[nj] = -INFINITY; lsum[nj] = 0.f;
#pragma unroll
        for (int md = 0; md < 4; ++md) Oa[md][nj] = (f32x4){0.f, 0.f, 0.f, 0.f}; }
    const float c1 = 0.125f * LOG2E;
    int voff[4];
    { const int q = fr >> 2, pp = fr & 3, x = (4 * g + q) & 7;
#pragma unroll
      for (int md = 0; md < 4; ++md) voff[md] = (4 * g + q) * VSTR + (((2 * md + (pp >> 1)) ^ x) * 16) + 8 * (pp & 1); }
    const int dkey = lane >> 3, dch = ((lane & 7) ^ (lane >> 3)) * 8;
    bf16x8 kn[2][2];
    { const KVSrc s = src(jt0); const unsigned klo = (unsigned)((fr * s.stride + 8 * g) * 2), vlo = (unsigned)((dkey * s.stride + dch) * 2);
#pragma unroll
      for (int mi = 0; mi < 2; ++mi) { const char* kb = (const char*)(s.k + (size_t)(16 * mi < s.nvalid ? 16 * mi : 0) * s.stride); kn[mi][0] = *(const bf16x8*)(kb + klo); kn[mi][1] = *(const bf16x8*)(kb + 64 + klo); }
      asm volatile("s_waitcnt lgkmcnt(0)" ::: "memory");
#pragma unroll
      for (int i = 0; i < 4; ++i) { const char* vb = (const char*)(s.v + (size_t)(8 * i < s.nvalid ? 8 * i : 0) * s.stride);
          __builtin_amdgcn_global_load_lds((const unsigned*)(vb + vlo), (LAS unsigned*)(vlds + i * 1024), 16, 0, 0); } }
    for (int jt = jt0; jt < jt1; ++jt) {
        const int buf = (jt - jt0) & 1; const bool more = jt + 1 < jt1;
        const KVSrc s = src(jt);
        bf16x8 kc[2][2];
#pragma unroll
        for (int mi = 0; mi < 2; ++mi) { kc[mi][0] = kn[mi][0]; kc[mi][1] = kn[mi][1]; }
        if (more) {
            const KVSrc sn = src(jt + 1); const unsigned klo = (unsigned)((fr * sn.stride + 8 * g) * 2), vlo = (unsigned)((dkey * sn.stride + dch) * 2);
#pragma unroll
            for (int mi = 0; mi < 2; ++mi) { const char* kb = (const char*)(sn.k + (size_t)(16 * mi < sn.nvalid ? 16 * mi : 0) * sn.stride); kn[mi][0] = *(const bf16x8*)(kb + klo); kn[mi][1] = *(const bf16x8*)(kb + 64 + klo); }
            asm volatile("s_waitcnt lgkmcnt(0)" ::: "memory");
#pragma unroll
            for (int i = 0; i < 4; ++i) { const char* vb = (const char*)(sn.v + (size_t)(8 * i < sn.nvalid ? 8 * i : 0) * sn.stride);
                __builtin_amdgcn_global_load_lds((const unsigned*)(vb + vlo), (LAS unsigned*)(vlds + (buf ^ 1) * 4096 + i * 1024), 16, 0, 0); }
        }
        f32x4 S[2][NJ];
#pragma unroll
        for (int mi = 0; mi < 2; ++mi)
#pragma unroll
            for (int nj = 0; nj < NJ; ++nj) { f32x4 a = {0.f, 0.f, 0.f, 0.f};
                a = __builtin_amdgcn_mfma_f32_16x16x32_bf16(kc[mi][0], qf[nj][0], a, 0, 0, 0); a = __builtin_amdgcn_mfma_f32_16x16x32_bf16(kc[mi][1], qf[nj][1], a, 0, 0, 0); S[mi][nj] = a; }
        const bool far = jt <= 11; const float bc = tbl[256];
        if (!far) { LAS const float* tb = tbl + (640 - 32 * jt - 64 + fr - 4 * g);
#pragma unroll
            for (int mi = 0; mi < 2; ++mi)
#pragma unroll
                for (int nj = 0; nj < NJ; ++nj)
#pragma unroll
                    for (int r = 0; r < 4; ++r) S[mi][nj][r] = S[mi][nj][r] * c1 + tb[64 + 16 * nj - 16 * mi - r];
            if (s.nvalid < 32) {
#pragma unroll
                for (int mi = 0; mi < 2; ++mi)
#pragma unroll
                    for (int nj = 0; nj < NJ; ++nj)
#pragma unroll
                        for (int r = 0; r < 4; ++r) if (16 * mi + 4 * g + r >= s.nvalid) S[mi][nj][r] = -INFINITY;
            }
        }
        float mx[NJ]; bool grow = false;
#pragma unroll
        for (int nj = 0; nj < NJ; ++nj) {
            float m = fmaxf(fmaxf(fmaxf(S[0][nj][0], S[0][nj][1]), fmaxf(S[0][nj][2], S[0][nj][3])), fmaxf(fmaxf(S[1][nj][0], S[1][nj][1]), fmaxf(S[1][nj][2], S[1][nj][3])));
            if (far) m = m * c1 + bc;
            mx[nj] = m; grow = grow || (m > mrun[nj] + 8.0f);
        }
        if (__builtin_amdgcn_ballot_w64(grow) != 0ull) {
#pragma unroll
            for (int nj = 0; nj < NJ; ++nj) { const float mnew = fmaxf(mrun[nj], rows_max(mx[nj])); const float alpha = __builtin_amdgcn_exp2f(mrun[nj] - mnew); mrun[nj] = mnew; lsum[nj] *= alpha;
#pragma unroll
                for (int md = 0; md < 4; ++md) Oa[md][nj] = Oa[md][nj] * alpha; }
        }
        bf16x8 pf[NJ];
        if (far) {
#pragma unroll
            for (int nj = 0; nj < NJ; ++nj) { float ps = 0.f; const float add = bc - mrun[nj];
#pragma unroll
                for (int mi = 0; mi < 2; ++mi)
#pragma unroll
                    for (int r = 0; r < 4; ++r) { const float pv = __builtin_amdgcn_exp2f(S[mi][nj][r] * c1 + add); S[mi][nj][r] = pv; ps += pv; }
                lsum[nj] += ps; }
        } else {
#pragma unroll
            for (int nj = 0; nj < NJ; ++nj) { float ps = 0.f;
#pragma unroll
                for (int mi = 0; mi < 2; ++mi)
#pragma unroll
                    for (int r = 0; r < 4; ++r) { const float pv = __builtin_amdgcn_exp2f(S[mi][nj][r] - mrun[nj]); S[mi][nj][r] = pv; ps += pv; }
                lsum[nj] += ps; }
        }
#pragma unroll
        for (int nj = 0; nj < NJ; ++nj) {
            u32x4 w; w.x = pk2(S[0][nj][0], S[0][nj][1]); w.y = pk2(S[0][nj][2], S[0][nj][3]); w.z = pk2(S[1][nj][0], S[1][nj][1]); w.w = pk2(S[1][nj][2], S[1][nj][3]);
            pf[nj] = __builtin_bit_cast(bf16x8, w);
        }
        if (more) asm volatile("s_waitcnt vmcnt(8)" ::: "memory"); else asm volatile("s_waitcnt vmcnt(0)" ::: "memory");
        LAS const unsigned char* vb = vlds + buf * 4096;
#pragma unroll
        for (int md = 0; md < 4; ++md) {
            const s16x4 lo = vtr(vb + voff[md]), hi = vtr(vb + voff[md] + 16 * VSTR);
            const bf16x8 vf = {lo[0], lo[1], lo[2], lo[3], hi[0], hi[1], hi[2], hi[3]};
#pragma unroll
            for (int nj = 0; nj < NJ; ++nj) Oa[md][nj] = __builtin_amdgcn_mfma_f32_16x16x32_bf16(vf, pf[nj], Oa[md][nj], 0, 0, 0);
        }
    }
#pragma unroll
    for (int nj = 0; nj < NJ; ++nj) {
        float l = rows_sum(lsum[nj]);
        const float inv = __builtin_amdgcn_rcpf(l); float ss = 0.f;
        char* orow = (char*)(O + (size_t)(16 * nj) * DM) + (unsigned)((fr * DM + 4 * g) * 2);
#pragma unroll
        for (int md = 0; md < 4; ++md) { const f32x4 o = Oa[md][nj] * inv; ss += (o[0] * o[0] + o[1] * o[1]) + (o[2] * o[2] + o[3] * o[3]);
            u32x2 w; w.x = pk2(o[0], o[1]); w.y = pk2(o[2], o[3]); *(u32x2*)(orow + 32 * md) = w; }
        ss = rows_sum(ss);
        if (g == 0) ssq[(16 * nj + fr) * 16] = ss;
    }
}

struct SrcPrompt { const bf16_t* kbase; int c;
    __device__ __forceinline__ KVSrc operator()(int jt) const { const bf16_t* k = kbase + ((ptrdiff_t)(c - 8) * 64 + jt * 32) * INC; return KVSrc{k, k + 512, INC, 32}; } };
struct SrcSample { const bf16_t* ck; const bf16_t* cv; const bf16_t* knew;
    __device__ __forceinline__ KVSrc operator()(int jt) const { if (jt < 16) return KVSrc{ck + (size_t)(jt * 32) * 512, cv + (size_t)(jt * 32) * 512, 512, 32}; return KVSrc{knew, knew + 512, INC, 16}; } };

__device__ __forceinline__ void attn_tables(const Params& p, unsigned char* lds, int tid) {
    const int lane = tid & 63, h = __builtin_amdgcn_readfirstlane(tid >> 6);
    LAS float* tbl = (LAS float*)((LAS unsigned char*)lds + A_TBL + h * 1280);
    for (int i = lane; i < 320; i += 64) tbl[i] = p.in[15][h * 257 + (i < 256 ? i : 256)] * LOG2E;
}
__device__ __forceinline__ void attn_wg_item(const Params& p, unsigned char* lds, int tid, int it, float* ssqA) {
    asm volatile("" : "+v"(tid));
    const int lane = tid & 63, h = __builtin_amdgcn_readfirstlane(tid >> 6);
    unsigned char* ws = p.ws;
    const bf16_t* PROJ = (const bf16_t*)(ws + WS_H); bf16_t* Y = (bf16_t*)(ws + WS_Y);
    const bf16_t* CK = (const bf16_t*)(ws + WS_CK); const bf16_t* CV = (const bf16_t*)(ws + WS_CV);
    LAS unsigned char* vlds = (LAS unsigned char*)lds + A_VT + h * 64 * VSTR; LAS float* tbl = (LAS float*)((LAS unsigned char*)lds + A_TBL + h * 1280);
    if (it < NB * 32) {
        const int c = 31 - (it >> 5), b = it & 31;
        const size_t r0 = (size_t)b * SEQ + (size_t)c * 64;
        SrcPrompt src{PROJ + (size_t)b * SEQ * INC + 1536 + 64 * h, c};
        attn_item<4, SrcPrompt>(vlds, tbl, PROJ + r0 * INC + 1024 + 64 * h, INC, src, c >= 8 ? 0 : 2 * (8 - c), 18, Y + r0 * DM + 512 + 64 * h, ssqA + r0 * 16 + 8 + h, lane);
    } else {
        const int b = it - NB * 32; const size_t r0 = (size_t)MP + (size_t)b * DSEQ;
        SrcSample src{CK + (size_t)b * 512 * 512 + 64 * h, CV + (size_t)b * 512 * 512 + 64 * h, PROJ + r0 * INC + 1536 + 64 * h};
        attn_item<1, SrcSample>(vlds, tbl, PROJ + r0 * INC + 1024 + 64 * h, INC, src, 0, 17, Y + r0 * DM + 512 + 64 * h, ssqA + r0 * 16 + 8 + h, lane);
    }
}

__device__ __forceinline__ void final_norm(const Params& p, int tid, int G) {
    const int lane = tid & 63, wave = tid >> 6; const int gw = blockIdx.x * NWAVES + wave, NGW = G * NWAVES;
    const float* ssq2 = (const float*)(p.ws + WS_SSQ2); const f32x4* gn = (const f32x4*)p.in[23] + lane;
    f32x4 gv[4];
#pragma unroll
    for (int j = 0; j < 4; ++j) gv[j] = gn[64 * j];
    const float* part = (const float*)(p.ws + WS_PART);
    for (int m = NGW - 1 - gw; m < MS; m += NGW) {
        f32x4* xr = (f32x4*)(p.out + (size_t)(MP + m) * DM) + lane; f32x4 v[4];
#pragma unroll
        for (int j = 0; j < 4; ++j) v[j] = xr[64 * j];
        for (int ks = 0; ks < 11; ++ks) { const f32x4* pr = (const f32x4*)(part + ((size_t)ks * MS + m) * DM) + lane;
#pragma unroll
            for (int j = 0; j < 4; ++j) v[j] += pr[64 * j]; }
        float s = 0.f;
#pragma unroll
        for (int j = 0; j < 4; ++j) s += (v[j].x * v[j].x + v[j].y * v[j].y) + (v[j].z * v[j].z + v[j].w * v[j].w);
        s = wave_sum(s); const float sc = __builtin_amdgcn_rsqf(s * (1.f / DM) + EPS);
#pragma unroll
        for (int j = 0; j < 4; ++j) xr[64 * j] = v[j] * sc * gv[j];
    }
}

#define RLX_AGENT __ATOMIC_RELAXED, __HIP_MEMORY_SCOPE_AGENT
#define XB_TMO      128
#define XB_XCNT(j)  (256  + 64 * (j))
#define XB_XSUB(j)  (1280 + 64 * (j))
#define XB_XGEN(j)  (2304 + 64 * (j))
#define XB_TOP      3328
#define XB_TOPGEN   3392
#define XCD_BAR_WORDS 3456
#define XB_SPIN_CAP (1u << 18)

__device__ __forceinline__ unsigned xb_ld(unsigned* p)              { return __hip_atomic_load(p, __ATOMIC_RELAXED, __HIP_MEMORY_SCOPE_AGENT); }
__device__ __forceinline__ unsigned xb_add(unsigned* p, unsigned v) { return __hip_atomic_fetch_add(p, v, __ATOMIC_RELAXED, __HIP_MEMORY_SCOPE_AGENT); }
__device__ __forceinline__ unsigned xb_xcc_id() { return (unsigned)__builtin_amdgcn_s_getreg((3 << 11) | 20) & 0xFu; }
#define XB_SPIN(cond, bar) do { unsigned _sp = 0; while (cond) { __builtin_amdgcn_s_sleep(1); \
    if ((++_sp & 255u) == 0u) { if (xb_ld(&(bar)[XB_TMO])) break; if (_sp > XB_SPIN_CAP) { atomicAdd(&(bar)[XB_TMO], 1u); break; } } } } while (0)

struct XcdBarrier {
    unsigned* bar; unsigned x;
    volatile LAS unsigned* st;
};

__device__ __forceinline__ XcdBarrier xcd_barrier_post(unsigned* bar, volatile LAS unsigned* st) {
    XcdBarrier b; b.bar = bar; b.x = xb_xcc_id(); b.st = st;
    if (threadIdx.x == 0) (void)xb_add(&bar[XB_XCNT(b.x)], 1u);
    return b;
}
__device__ __forceinline__ void xcd_barrier_complete(unsigned* bar, unsigned x, unsigned& nloc, unsigned& nx) {
    const unsigned G = gridDim.x * gridDim.y * gridDim.z;
    unsigned sum, cnt, mine, sp = 0u;
    for (;;) {
        sum = 0u; cnt = 0u; mine = 0u;
#pragma unroll
        for (unsigned j = 0; j < 16; ++j) { const unsigned c = xb_ld(&bar[XB_XCNT(j)]); sum += c; cnt += (c > 0u) ? 1u : 0u; mine = (j == x) ? c : mine; }
        if (sum == G) break;
        __builtin_amdgcn_s_sleep(1);
        if ((++sp & 255u) == 0u) { if (xb_ld(&bar[XB_TMO])) break; if (sp > XB_SPIN_CAP) { atomicAdd(&bar[XB_TMO], 1u); break; } }
    }
    nloc = mine > 0u ? mine : 1u; nx = cnt > 0u ? cnt : 1u;
}

__device__ __forceinline__ void xcd_barrier(const XcdBarrier& b) {
    asm volatile("s_waitcnt vmcnt(0)" ::: "memory");
    __syncthreads();
    if (threadIdx.x == 0) {
        unsigned* bar = b.bar;
        __builtin_amdgcn_s_waitcnt(0);
        unsigned nloc = b.st[0], nx = b.st[1];
        if (nloc == 0u) { xcd_barrier_complete(bar, b.x, nloc, nx); b.st[0] = nloc; b.st[1] = nx; }
        const unsigned old = xb_add(&bar[XB_XSUB(b.x)], 1u);
        const unsigned gen = old / nloc;
        if (old + 1u == (gen + 1u) * nloc) {
            __builtin_amdgcn_fence(__ATOMIC_RELEASE, "agent");
            asm volatile("s_waitcnt vmcnt(0)" ::: "memory");
            const unsigned og = xb_add(&bar[XB_TOP], 1u);
            const unsigned tg = og / nx;
            if (og + 1u == (tg + 1u) * nx) xb_add(&bar[XB_TOPGEN], 1u);
            else XB_SPIN(xb_ld(&bar[XB_TOPGEN]) == tg, bar);
            __builtin_amdgcn_fence(__ATOMIC_ACQUIRE, "agent");
            xb_add(&bar[XB_XGEN(b.x)], 1u);
            asm volatile("s_waitcnt vmcnt(0)" ::: "memory");
        } else {
            XB_SPIN(xb_ld(&bar[XB_XGEN(b.x)]) == gen, bar);
            __builtin_amdgcn_fence(__ATOMIC_ACQUIRE, "agent");
            asm volatile("s_waitcnt vmcnt(0)" ::: "memory");
        }
    }
    __syncthreads();
}

#ifndef DIS_G1
#define DIS_G1 0
#endif
#ifndef DIS_G2
#define DIS_G2 0
#endif
#ifndef DIS_G3
#define DIS_G3 0
#endif
#ifndef DIS_G4
#define DIS_G4 0
#endif
__global__ void __launch_bounds__(NTHR, 2) mega_fwd(Params p, int ph_lo, int ph_hi) {
    extern __shared__ __attribute__((aligned(16))) unsigned char lds[];
    cg::grid_group grid = cg::this_grid();
    const int tid = threadIdx.x, G = gridDim.x;
    unsigned char* ws = p.ws;
#define IN(k) (ph_lo <= (k) && (k) < ph_hi)
    volatile LAS unsigned* bst = (volatile LAS unsigned*)((LAS unsigned char*)lds + LDS_BYTES - 32);
    if (tid < 2) bst[tid] = 0u;
    __syncthreads();
    XcdBarrier xbar; xbar.bar = (unsigned*)(ws + WS_BAR); xbar.x = 0; xbar.st = bst;
#define SEAM(k) do { if (IN(k) && IN((k) + 1)) { if ((k) == 0) { grid.sync(); xbar = xcd_barrier_post((unsigned*)(ws + WS_BAR), bst); } else xcd_barrier(xbar); } } while (0)
    if (IN(0)) { p0_prologue(p, lds, tid, G); }
    SEAM(0);
#ifndef DIS_GEMM
    if (IN(1) && !DIS_G1) {
        pg8::Gemm g{(const bf16_t*)(ws + WS_XB), (const bf16_t*)(ws + WS_W1), MT, INC, DM}; pg8::StaticOrder S; S.init(MT, INC, G, (int)blockIdx.x);
        pg8::Epi1 E{(bf16_t*)(ws + WS_H), (const float*)(ws + WS_RS1), p.out};
        pg8::gemm_phase<pg8::Epi1, pg8::StaticOrder, PG8_ALIGN, PG8_SP2>((LAS unsigned char*)lds, g, S, E);
        if (G == 256) { p0_weights(p, lds, tid, WI_1, WI_2, 20, 236); p0_cache(p, tid, 20, 236); } else { p0_weights(p, lds, tid, WI_1, WI_2, 0, G); p0_cache(p, tid, 0, G); }
    }
#endif
    SEAM(1);
    if (IN(2)) {
        attn_tables(p, lds, tid);
        LAS unsigned* qslot = (LAS unsigned*)((LAS unsigned char*)lds + LDS_BYTES - 16);
        unsigned* ctr = (unsigned*)(ws + WS_CTR);
        const unsigned xcc = xb_xcc_id() & 7u;
        for (unsigned qo = 0; qo < 8; ++qo) {
            const int q = (int)((xcc + qo) & 7u);
            for (;;) {
                __syncthreads();
                if (tid == 0) *qslot = atomicAdd(ctr + 64 * q, 1u);
                __syncthreads();
                const int it = __builtin_amdgcn_readfirstlane((int)*qslot);
                if (it >= 196) break;
                int aj = -1;
                if (it < 64) { if (it & 1) aj = it >> 1; else { const int j = it >> 1; lru_item(p, lds, tid, q + 8 * (j >> 3), j & 7, false, (float*)(ws + WS_SSQP)); } }
                else if (it < 96) { const int j = it - 64; lru_item(p, lds, tid, q + 8 * (j >> 3), j & 7, true, (float*)(ws + WS_SSQP)); }
                else if (it < 100) attn_wg_item(p, lds, tid, NB * 32 + q + 8 * (it - 96), (float*)(ws + WS_SSQP));
                else aj = 32 + (it - 100);
                if (aj >= 0) attn_wg_item(p, lds, tid, ((aj & 31) << 5) | (q + 8 * (aj >> 5)), (float*)(ws + WS_SSQP));
            }
        }
    }
    SEAM(2);
#ifndef DIS_GEMM
    if (IN(3) && !DIS_G2) {
        pg8::Gemm g{(const bf16_t*)(ws + WS_Y), (const bf16_t*)(ws + WS_W2), MT, DM, DM}; pg8::StaticOrder S; S.init(MT, DM, G, (int)blockIdx.x);
        LAS float* tab = (LAS float*)((LAS unsigned char*)lds + 131072);
        { const f32x4* sp = (const f32x4*)(ws + WS_SSQP); pg8::Unit u;
          for (int i = 0; i < 6; ++i) { if (!S.next(i, u)) break; if (tid < 256) { const int row = u.pm * 256 + tid; const f32x4 l0 = sp[row * 4], l1 = sp[row * 4 + 1], a0 = sp[row * 4 + 2], a1 = sp[row * 4 + 3];
              const float l = (((l0.x + l0.y) + (l0.z + l0.w)) + ((l1.x + l1.y) + (l1.z + l1.w))) * (1.f / 512.f) + EPS, a = (((a0.x + a0.y) + (a0.z + a0.w)) + ((a1.x + a1.y) + (a1.z + a1.w))) * (1.f / 512.f) + EPS;
              tab[(i * 256 + tid) * 2] = sqrtf(a / l); tab[(i * 256 + tid) * 2 + 1] = __builtin_amdgcn_rsqf(a); } }
          __syncthreads(); }
        pg8::Epi2 E{p.in[0], p.in[1], p.out, (bf16_t*)(ws + WS_XB), tab, (float*)(ws + WS_SSQ1)};
        pg8::gemm_phase<pg8::Epi2, pg8::StaticOrder, PG8_ALIGN, PG8_SP2>((LAS unsigned char*)lds, g, S, E);
        if (G == 256) p0_weights(p, lds, tid, WI_2, WI_END, 8, 248); else p0_weights(p, lds, tid, WI_2, WI_END, 0, G);
    }
    if (IN(3)) SEAM(3);
    if (IN(4) && !DIS_G3) {
        pg8::Gemm g{(const bf16_t*)(ws + WS_XB), (const bf16_t*)(ws + WS_W3), MT, 2 * DFF, DM}; pg8::StaticOrder S; S.init(MT, 2 * DFF, G, (int)blockIdx.x);
        pg8::Epi3 E{(bf16_t*)(ws + WS_H), (const float*)(ws + WS_SSQ1)};
        pg8::gemm_phase<pg8::Epi3, pg8::StaticOrder, PG8_ALIGN, PG8_SP2>((LAS unsigned char*)lds, g, S, E);
    }
    if (IN(4)) SEAM(4);
    if (IN(5) && !DIS_G4) {
        { pg8::Gemm g{(const bf16_t*)(ws + WS_H), (const bf16_t*)(ws + WS_W4), MP, DM, DFF}; pg8::StaticOrder S; S.init(MP, DM, G, (int)blockIdx.x);
          pg8::Epi4N E{p.out, (const bf16_t*)(ws + WS_XB), p.in[23], (float*)(ws + WS_SLOT), (unsigned*)(ws + WS_PCNT), (LAS unsigned char*)lds + 131072};
          pg8::gemm_phase<pg8::Epi4N, pg8::StaticOrder, PG8_ALIGN, PG8_SP2>((LAS unsigned char*)lds, g, S, E); }
        for (int pc = (int)blockIdx.x; pc < 88; pc += G) { const int ks = pc % 11, un = pc / 11;
          pg8::Gemm g{(const bf16_t*)(ws + WS_H) + ks * 256, (const bf16_t*)(ws + WS_W4) + ks * 256, MT, DM, 256, DFF}; pg8::OneUnit S{256 + un / 4, un % 4};
          pg8::Epi4P E{(float*)(ws + WS_PART) + (size_t)ks * MS * DM};
          pg8::gemm_phase<pg8::Epi4P, pg8::OneUnit, false, PG8_SP2>((LAS unsigned char*)lds, g, S, E); }
    }
#endif
    SEAM(5);
    if (IN(6)) { final_norm(p, tid, G); }
#undef IN
#undef SEAM
}

extern "C" void kernel_launch(void* const* d_in, const int* in_sizes, int n_in, void* d_out, int out_size, void* d_ws, size_t ws_size, hipStream_t stream) {
    static int grid = 0;
    if (grid == 0) {
        if (n_in != 24 || (size_t)out_size != pg8::EO_END || ws_size < WS_END) { fprintf(stderr, "kernel_launch: unexpected shapes: n_in %d out %d ws %zu\n", n_in, out_size, ws_size); grid = -1; return; }
        int dev = 0, cus = 0, per_cu = 0;
        hipGetDevice(&dev); hipDeviceGetAttribute(&cus, hipDeviceAttributeMultiprocessorCount, dev);
        if (hipFuncSetAttribute((const void*)mega_fwd, hipFuncAttributeMaxDynamicSharedMemorySize, LDS_BYTES) != hipSuccess) { fprintf(stderr, "kernel_launch: hipFuncSetAttribute failed\n"); grid = -1; return; }
        if (hipOccupancyMaxActiveBlocksPerMultiprocessor(&per_cu, (const void*)mega_fwd, NTHR, LDS_BYTES) != hipSuccess || per_cu < 1) { fprintf(stderr, "kernel_launch: occupancy query says %d\n", per_cu); per_cu = 1; }
        (void)hipGetLastError();
        grid = cus * 1;
        fprintf(stderr, "kernel_launch: grid %d (cus %d, per_cu %d)\n", grid, cus, per_cu);
    }
    if (grid < 0) return;
    Params p{};
    for (int i = 0; i < 24; ++i) p.in[i] = (const float*)d_in[i];
    p.out = (float*)d_out; p.ws = (unsigned char*)d_ws;
#if defined(MK_MULTI)
    for (int ph = 0; ph < 7; ++ph) { int lo = ph, hi = ph + 1; void* args[] = {&p, &lo, &hi};
        hipError_t e = hipLaunchCooperativeKernel((void*)mega_fwd, dim3(grid), dim3(NTHR), args, LDS_BYTES, stream);
        if (e != hipSuccess) fprintf(stderr, "launch %d failed: %s\n", ph, hipGetErrorString(e)); }
#else
    int lo = 0, hi = 7; void* args[] = {&p, &lo, &hi};
    hipError_t e = hipLaunchCooperativeKernel((void*)mega_fwd, dim3(grid), dim3(NTHR), args, LDS_BYTES, stream);
    if (e != hipSuccess) fprintf(stderr, "cooperative launch failed: %s (grid %d)\n", hipGetErrorString(e), grid);
#endif
}
```
